# Optimizing an MI355X kernel written in HIP

```python
import jax, jax.numpy as jnp
from jax import lax
import numpy as np

D_MODEL = 2048
BATCH = 4
SEQ = 2048
DEPTH = 2

N_MIXERS = 2
N_LAYERS_A = (DEPTH + N_MIXERS - 1) // N_MIXERS
N_LAYERS_B = DEPTH // N_MIXERS
CHUNK = 64
EPS = 1e-6

A_HEADS = 8
A_DV = D_MODEL // A_HEADS
A_DK = A_DV // 2
A_QK = A_HEADS * A_DK
A_V = A_HEADS * A_DV
A_IN = 2 * A_QK + 2 * A_V + 4 * A_HEADS

B_EXPAND = 128
B_HEADS = D_MODEL // B_EXPAND
B_DK = B_EXPAND
B_DV = D_MODEL // B_HEADS
B_F = B_HEADS * B_DK
B_V = B_HEADS * B_DV
B_IN = 3 * B_F + 2 * B_V

D_FF = 5504
CONV_W = 3

kernel_name = "hybrid_mlstm_hgrn2_convglu_encoder"


def rmsnorm(x, g):
    xf = x.astype(jnp.float32)
    xf = xf * lax.rsqrt(jnp.mean(xf * xf, axis=-1, keepdims=True) + EPS)
    return xf.astype(x.dtype) * g


def head_rmsnorm(y, g, n_heads):
    b, s, w = y.shape
    yf = y.astype(jnp.float32).reshape(b, s, n_heads, w // n_heads)
    yf = yf * lax.rsqrt(jnp.mean(yf * yf, axis=-1, keepdims=True) + EPS)
    return yf.reshape(b, s, w).astype(y.dtype) * g


def to_chunks(t):
    b, s = t.shape[0], t.shape[1]
    t = t.reshape((b, s // CHUNK, CHUNK) + t.shape[2:])
    perm = (1, 0, 3, 2) + tuple(range(4, t.ndim))
    return t.transpose(perm)


def from_chunks(t):
    nc, b, h, l, d = t.shape
    return t.transpose(1, 0, 3, 2, 4).reshape(b, nc * l, h, d)


def _mlstm_chunk(carry, xs):
    c_st, n_st, m_st = carry
    q, k, v, ig, lf = xs
    L = q.shape[2]
    b = jnp.cumsum(lf, axis=-1)
    g_tot = b[..., -1]
    lower = jnp.tril(jnp.ones((L, L), dtype=bool))
    d = jnp.where(lower, b[..., :, None] - b[..., None, :] + ig[..., None, :], -jnp.inf)
    m_inter = b + m_st[..., None]
    m_t = jnp.maximum(jnp.max(d, axis=-1), m_inter)
    s = jnp.einsum('bhtk,bhsk->bhts', q, k) * jnp.exp(d - m_t[..., None])
    w_inter = jnp.exp(m_inter - m_t)
    num = jnp.einsum('bhts,bhsv->bhtv', s, v) + w_inter[..., None] * jnp.einsum('bhtk,bhvk->bhtv', q, c_st)
    den = jnp.sum(s, axis=-1) + w_inter * jnp.einsum('bhtk,bhk->bht', q, n_st)
    h = num / jnp.maximum(jnp.abs(den), jnp.exp(-m_t))[..., None]
    a = g_tot[..., None] - b + ig
    m_new = jnp.maximum(g_tot + m_st, jnp.max(a, axis=-1))
    w_s = jnp.exp(a - m_new[..., None])
    decay = jnp.exp(g_tot + m_st - m_new)
    c_st = decay[..., None, None] * c_st + jnp.einsum('bhs,bhsv,bhsk->bhvk', w_s, v, k)
    n_st = decay[..., None] * n_st + jnp.einsum('bhs,bhsk->bhk', w_s, k)
    return (c_st, n_st, m_new), h


def mlstm_direction(q, k, v, ig, lf):
    b, _, h, dk = q.shape
    dv = v.shape[-1]
    init = (jnp.zeros((b, h, dv, dk), jnp.float32), jnp.zeros((b, h, dk), jnp.float32),
            jnp.zeros((b, h), jnp.float32))
    xs = (to_chunks(q), to_chunks(k), to_chunks(v), to_chunks(ig), to_chunks(lf))
    _, out = lax.scan(_mlstm_chunk, init, xs)
    return from_chunks(out)


def mlstm_mixer(hn, w_in, b_gate, head_g, w_out):
    b, s, _ = hn.shape
    p = hn @ w_in
    q, k, v, o, gates = jnp.split(p, [A_QK, 2 * A_QK, 2 * A_QK + A_V, 2 * A_QK + 2 * A_V], axis=-1)
    gates = (gates + b_gate).astype(jnp.float32).reshape(b, s, 4, A_HEADS)
    ig_f, lf_f = gates[:, :, 0], jax.nn.log_sigmoid(gates[:, :, 1])
    ig_b, lf_b = gates[:, :, 2], jax.nn.log_sigmoid(gates[:, :, 3])
    q = q.astype(jnp.float32).reshape(b, s, A_HEADS, A_DK) * (A_DK ** -0.5)
    k = k.astype(jnp.float32).reshape(b, s, A_HEADS, A_DK)
    v = v.astype(jnp.float32).reshape(b, s, A_HEADS, A_DV)
    fl = lambda t: jnp.flip(t, axis=1)
    y = mlstm_direction(q, k, v, ig_f, lf_f) + fl(mlstm_direction(fl(q), fl(k), fl(v), fl(ig_b), fl(lf_b)))
    y = y.reshape(b, s, A_V).astype(hn.dtype)
    y = head_rmsnorm(y, head_g, A_HEADS) * jax.nn.sigmoid(o)
    return y @ w_out


def _hgrn_chunk(s_st, xs):
    q, k, lf, v = xs
    L = q.shape[2]
    b = jnp.cumsum(lf, axis=2)
    lower = jnp.tril(jnp.ones((L, L), dtype=bool))
    rel = jnp.where(lower[:, :, None], b[:, :, :, None, :] - b[:, :, None, :, :], -jnp.inf)
    attn = jnp.einsum('bhtsk,bhsk->bhts', jnp.exp(rel) * q[:, :, :, None, :], k)
    o = jnp.einsum('bhts,bhsv->bhtv', attn, v) + jnp.einsum('bhtk,bhkv->bhtv', q * jnp.exp(b), s_st)
    b_end = b[:, :, -1]
    s_st = jnp.exp(b_end)[..., None] * s_st + jnp.einsum('bhsk,bhsv->bhkv', k * jnp.exp(b_end[:, :, None] - b), v)
    return s_st, o


def hgrn_direction(q, k, lf, v):
    b, _, h, dk = q.shape
    dv = v.shape[-1]
    init = jnp.zeros((b, h, dk, dv), jnp.float32)
    _, out = lax.scan(_hgrn_chunk, init, (to_chunks(q), to_chunks(k), to_chunks(lf), to_chunks(v)))
    return from_chunks(out)


def hgrn_mixer(hn, w_in, lb, head_g, w_out):
    b, s, _ = hn.shape
    p = hn @ w_in
    q, i, g, f_f, f_b = jnp.split(p, [B_F, B_F + B_V, B_F + 2 * B_V, 2 * B_F + 2 * B_V], axis=-1)
    log_lb, log_1mlb = jnp.log(lb), jnp.log1p(-lb)

    def gate(f):
        f = f.astype(jnp.float32)
        log_f = jnp.logaddexp(log_lb, log_1mlb + jax.nn.log_sigmoid(f))
        k = (1.0 - lb) * jax.nn.sigmoid(-f)
        return (k.reshape(b, s, B_HEADS, B_DK), log_f.reshape(b, s, B_HEADS, B_DK))

    k_f, lf_f = gate(f_f)
    k_b, lf_b = gate(f_b)
    q = q.astype(jnp.float32).reshape(b, s, B_HEADS, B_DK)
    v = i.astype(jnp.float32).reshape(b, s, B_HEADS, B_DV)
    fl = lambda t: jnp.flip(t, axis=1)
    y = hgrn_direction(q, k_f, lf_f, v) + fl(hgrn_direction(fl(q), fl(k_b), fl(lf_b), fl(v)))
    y = y.reshape(b, s, B_V).astype(hn.dtype)
    y = head_rmsnorm(y, head_g, B_HEADS) * jax.nn.silu(g)
    return y @ w_out


def conv_glu(hn, w_up, conv_w, conv_b, w_down):
    u = hn @ w_up
    a, v = jnp.split(u, 2, axis=-1)
    s = a.shape[1]
    pad = CONV_W // 2
    ap = jnp.pad(a, ((0, 0), (pad, pad), (0, 0)))
    c = conv_b
    for j in range(CONV_W):
        c = c + ap[:, j:j + s] * conv_w[j]
    return (jax.nn.gelu(c, approximate=False) * v) @ w_down


def setup_inputs(seed: int = 0) -> dict:
    key = jax.random.key(seed)
    ks = jax.random.split(key, 20)
    f32 = jnp.float32
    nrm = lambda k, shape, scale: jax.random.normal(k, shape, f32) * scale
    i_bias = -3.0 + 0.1 * jax.random.normal(ks[0], (N_LAYERS_A, 2, A_HEADS), f32)
    f_bias = jnp.linspace(3.0, 6.0, A_HEADS, dtype=f32) + 0.1 * jax.random.normal(ks[1], (N_LAYERS_A, 2, A_HEADS), f32)
    b_gate = jnp.stack([i_bias[:, 0], f_bias[:, 0], i_bias[:, 1], f_bias[:, 1]], axis=1).reshape(N_LAYERS_A, 4 * A_HEADS)
    return {
        "x": jax.random.normal(ks[2], (BATCH, SEQ, D_MODEL), f32),
        "norm_mix_g": 1.0 + nrm(ks[3], (DEPTH, D_MODEL), 0.02),
        "norm_ffn_g": 1.0 + nrm(ks[4], (DEPTH, D_MODEL), 0.02),
        "mlstm_w_in": nrm(ks[5], (N_LAYERS_A, D_MODEL, A_IN), D_MODEL ** -0.5),
        "mlstm_b_gate": b_gate,
        "mlstm_head_g": 1.0 + nrm(ks[6], (N_LAYERS_A, A_V), 0.02),
        "mlstm_w_out": nrm(ks[7], (N_LAYERS_A, A_V, D_MODEL), A_V ** -0.5),
        "hgrn_w_in": nrm(ks[8], (N_LAYERS_B, D_MODEL, B_IN), D_MODEL ** -0.5),
        "hgrn_lb": nrm(ks[9], (DEPTH, B_F), 0.5),
        "hgrn_head_g": 1.0 + nrm(ks[10], (N_LAYERS_B, B_V), 0.02),
        "hgrn_w_out": nrm(ks[11], (N_LAYERS_B, B_V, D_MODEL), B_V ** -0.5),
        "ffn_w_up": nrm(ks[12], (DEPTH, D_MODEL, 2 * D_FF), D_MODEL ** -0.5),
        "ffn_conv_w": nrm(ks[13], (DEPTH, CONV_W, D_FF), CONV_W ** -0.5),
        "ffn_conv_b": nrm(ks[14], (DEPTH, D_FF), 0.02),
        "ffn_w_down": nrm(ks[15], (DEPTH, D_FF, D_MODEL), D_FF ** -0.5),
        "final_g": 1.0 + nrm(ks[16], (D_MODEL,), 0.02),
    }


def reference(x, norm_mix_g, norm_ffn_g, mlstm_w_in, mlstm_b_gate, mlstm_head_g, mlstm_w_out,
              hgrn_w_in, hgrn_lb, hgrn_head_g, hgrn_w_out, ffn_w_up, ffn_conv_w, ffn_conv_b,
              ffn_w_down, final_g):
    sm = jax.nn.softmax(hgrn_lb.astype(jnp.float32), axis=0)
    lower_bounds = jnp.cumsum(sm, axis=0) - sm[0]
    h = x
    for layer in range(DEPTH):
        j = layer // N_MIXERS
        hn = rmsnorm(h, norm_mix_g[layer])
        if layer % N_MIXERS == 0:
            mix = mlstm_mixer(hn, mlstm_w_in[j], mlstm_b_gate[j], mlstm_head_g[j], mlstm_w_out[j])
        else:
            mix = hgrn_mixer(hn, hgrn_w_in[j], lower_bounds[layer], hgrn_head_g[j], hgrn_w_out[j])
        h = h + mix
        h = h + conv_glu(rmsnorm(h, norm_ffn_g[layer]), ffn_w_up[layer], ffn_conv_w[layer],
                         ffn_conv_b[layer], ffn_w_down[layer])
    return rmsnorm(h, final_g)
```

```cpp
#include <hip/hip_runtime.h>
#include <hip/hip_cooperative_groups.h>
#include <cstdio>
#include <cstdint>
namespace cg = cooperative_groups;
namespace pg8 {
#define PG8_LAS __attribute__((address_space(3)))
typedef unsigned short bf16_t;
typedef short bf16x8 __attribute__((ext_vector_type(8)));
typedef float f32x4 __attribute__((ext_vector_type(4)));
typedef unsigned u32x4 __attribute__((ext_vector_type(4)));
constexpr int BM = 256, BK = 64, HALF = 128, HTB = HALF * BK * 2  , STAGE_BYTES = 8 * HTB, NXCD = 8, WGM = 4;

__host__ __device__ __forceinline__ int lds_byte(int r, int c) { const int st = (r >> 4) * 2 + (c >> 5), rr = r & 15, cc = c & 31, ob = rr * 64 + cc * 2; return st * 1024 + (ob ^ (((ob >> 9) & 1) << 5)); }
__host__ __device__ __forceinline__ void stage_rc(int b, int& R, int& C) { const int st = b / 1024, sb = b % 1024, swz = sb ^ (((sb >> 9) & 1) << 5); R = (st >> 1) * 16 + swz / 64; C = (st & 1) * 32 + (swz % 64) / 2; }
__host__ __device__ __forceinline__ int perm32(int rho) { const int n = rho >> 4, i = rho & 15; return 8 * (i >> 2) + 4 * n + (i & 3); }

struct Unit { int pm, pn; };
struct Gemm { const bf16_t* A; const bf16_t* Bt; int M, N, K; };

struct StaticOrder {
    int nM, nN, nwg, G, c;
    __host__ __device__ void init(int M, int N, int G_, int c_) { nM = M / BM; nN = N / BM; nwg = nM * nN; G = G_; c = c_; }
    __host__ __device__ bool next(int i, Unit& u) const {
        const long L = (long)i * G + c; if (L >= nwg) return false;
        int wgid = (int)L; { const int q = nwg / NXCD, r = nwg % NXCD, xcd = wgid % NXCD, off = wgid / NXCD; wgid = (xcd < r ? xcd * (q + 1) : r * (q + 1) + (xcd - r) * q) + off; }
        const int nig = WGM * nN, gid = wgid / nig, fm = gid * WGM, gsz = (nM - fm) < WGM ? (nM - fm) : WGM;
        u.pm = fm + ((wgid % nig) % gsz); u.pn = (wgid % nig) / gsz; return true;
    }
    __device__ __forceinline__ void a_ready(const Unit&) const {}
    __device__ __forceinline__ void done(const Unit&) const {}
};

typedef __bf16 bf16x2v __attribute__((ext_vector_type(2)));
typedef float f32x2v_ __attribute__((ext_vector_type(2)));
__device__ __forceinline__ unsigned cvt_pk_bf16(float lo, float hi) { f32x2v_ f = {lo, hi}; bf16x2v v = __builtin_convertvector(f, bf16x2v); return __builtin_bit_cast(unsigned, v); }
typedef float f32x2 __attribute__((ext_vector_type(2)));
__device__ __forceinline__ f32x2 gelu_pk(f32x2 v) {
    const f32x2 av = __builtin_elementwise_abs(v), d = av * 0.2316418882f + 1.0f;
    f32x2 t; t.x = __builtin_amdgcn_rcpf(d.x); t.y = __builtin_amdgcn_rcpf(d.y);
    f32x2 q = t * 0.5307027145f + (-0.7265760135f); q = q * t + 0.7107068705f; q = q * t + (-0.142248368f); q = q * t + 0.127414796f; q = q * t;
    const f32x2 s = (v * v) * (-0.72134752044f);
    f32x2 e; e.x = __builtin_amdgcn_exp2f(s.x); e.y = __builtin_amdgcn_exp2f(s.y);
    const f32x2 m = v * (q * e), r = v - m;
    f32x2 o; o.x = v.x < 0.f ? m.x : r.x; o.y = v.y < 0.f ? m.y : r.y; return o;
}


struct SubOrder : StaticOrder {
    int lo, hi;
    __host__ __device__ bool next(int i, Unit& u) const {
        const long L = (long)lo + (long)i * G + c; if (L >= hi) return false;
        int wgid = (int)L; { const int q = nwg / NXCD, r = nwg % NXCD, xcd = wgid % NXCD, off = wgid / NXCD; wgid = (xcd < r ? xcd * (q + 1) : r * (q + 1) + (xcd - r) * q) + off; }
        const int nig = WGM * nN, gid = wgid / nig, fm = gid * WGM, gsz = (nM - fm) < WGM ? (nM - fm) : WGM;
        u.pm = fm + ((wgid % nig) % gsz); u.pn = (wgid % nig) / gsz; return true;
    }
};

template <int MODE> struct EpiX {
    static constexpr bool PERM = true, AFTER_DRAIN = false;
    bf16_t* O; int ldc; float* G; const float* aux; const float* ss;
    __device__ __forceinline__ void operator()(const f32x4 (&acc)[2][2][4][2], const Unit& u, int wr, int wc, int fr, int fq) const {
        const int row0 = u.pm * BM + wr * 64 + fr; const int colt = u.pn * BM;
        const float sc = (MODE == 1 && colt < 1024) ? 0.08838834764831845f : 1.0f;
        const int col0 = colt + wc * 32 + 8 * fq;
        const bool lfmode = (MODE == 2) && (colt >= 6144);
        float lb[2][8];
        if (MODE == 2) {
#pragma unroll
            for (int bj = 0; bj < 2; ++bj) {
                if (lfmode) { const int ci = (col0 + bj * HALF - 6144) & 2047;
                    const f32x4 l00 = *(const f32x4*)(aux + ci), l01 = *(const f32x4*)(aux + ci + 4), l10 = *(const f32x4*)(aux + 2048 + ci), l11 = *(const f32x4*)(aux + 2048 + ci + 4);
#pragma unroll
                    for (int e = 0; e < 4; ++e) { lb[bj][e] = 1.0f / (1.0f + __expf(l00[e] - l10[e])); lb[bj][4 + e] = 1.0f / (1.0f + __expf(l01[e] - l11[e])); } }
                else {
#pragma unroll
                    for (int e = 0; e < 8; ++e) lb[bj][e] = 0.f; } }
        }
#pragma unroll
        for (int ai = 0; ai < 2; ++ai) {
            f32x4 t4[4];
#pragma unroll
            for (int m = 0; m < 4; ++m) { const f32x4* sp = (const f32x4*)(ss + (size_t)(row0 + ai * HALF + m * 16) * 32) + 2 * fq;
                t4[m] = sp[0] + sp[1]; }
            float rs[4];
#pragma unroll
            for (int m = 0; m < 4; ++m) { float tq = (t4[m][0] + t4[m][1]) + (t4[m][2] + t4[m][3]); tq += __shfl_xor(tq, 16); tq += __shfl_xor(tq, 32);
                rs[m] = rsqrtf(tq * (1.0f / 2048.0f) + 1e-6f) * sc; }
#pragma unroll
            for (int bj = 0; bj < 2; ++bj)
#pragma unroll
                for (int m = 0; m < 4; ++m) { bf16_t* rowp = O + (size_t)(row0 + ai * HALF + m * 16) * ldc + col0 + bj * HALF;
                    f32x4 v0 = acc[ai][bj][m][0] * rs[m], v1 = acc[ai][bj][m][1] * rs[m];
                    if (MODE == 2) { if (lfmode) {
#pragma unroll
                        for (int e = 0; e < 4; ++e) { const float s0 = __builtin_amdgcn_rcpf(1.0f + __expf(-v0[e])), s1 = __builtin_amdgcn_rcpf(1.0f + __expf(-v1[e]));
                            v0[e] = __logf(lb[bj][e] + (1.0f - lb[bj][e]) * s0); v1[e] = __logf(lb[bj][4 + e] + (1.0f - lb[bj][4 + e]) * s1); } } }
                    u32x4 w; w.x = cvt_pk_bf16(v0[0], v0[1]); w.y = cvt_pk_bf16(v0[2], v0[3]); w.z = cvt_pk_bf16(v1[0], v1[1]); w.w = cvt_pk_bf16(v1[2], v1[3]);
                    *(u32x4*)rowp = w; }
        }
    }
};
template <bool RESF32, bool WITH_SS> struct EpiRes {
    static constexpr bool PERM = true, AFTER_DRAIN = false;
    const float* resf; int ldc; bf16_t* hn; float* ss;
    __device__ __forceinline__ void operator()(const f32x4 (&acc)[2][2][4][2], const Unit& u, int wr, int wc, int fr, int fq) const {
        const int row0 = u.pm * BM + wr * 64 + fr, col0 = u.pn * BM + wc * 32 + 8 * fq;
#pragma unroll
        for (int ai = 0; ai < 2; ++ai) {
            f32x4 r0[4][2], r1[4][2];
            if (RESF32) {
#pragma unroll
                for (int m = 0; m < 4; ++m)
#pragma unroll
                    for (int bj = 0; bj < 2; ++bj) { const size_t off = (size_t)(row0 + ai * HALF + m * 16) * ldc + col0 + bj * HALF; r0[m][bj] = *(const f32x4*)(resf + off); r1[m][bj] = *(const f32x4*)(resf + off + 4); }
            } else {
                u32x4 rw[4][2];
#pragma unroll
                for (int m = 0; m < 4; ++m)
#pragma unroll
                    for (int bj = 0; bj < 2; ++bj) rw[m][bj] = *(const u32x4*)(hn + (size_t)(row0 + ai * HALF + m * 16) * ldc + col0 + bj * HALF);
#pragma unroll
                for (int m = 0; m < 4; ++m)
#pragma unroll
                    for (int bj = 0; bj < 2; ++bj) { const u32x4 w = rw[m][bj];
                        r0[m][bj] = (f32x4){__builtin_bit_cast(float, w.x << 16), __builtin_bit_cast(float, w.x & 0xffff0000u), __builtin_bit_cast(float, w.y << 16), __builtin_bit_cast(float, w.y & 0xffff0000u)};
                        r1[m][bj] = (f32x4){__builtin_bit_cast(float, w.z << 16), __builtin_bit_cast(float, w.z & 0xffff0000u), __builtin_bit_cast(float, w.w << 16), __builtin_bit_cast(float, w.w & 0xffff0000u)}; }
            }
#pragma unroll
            for (int m = 0; m < 4; ++m) { const int row = row0 + ai * HALF + m * 16; const size_t off = (size_t)row * ldc + col0; float q = 0.f;
#pragma unroll
                for (int bj = 0; bj < 2; ++bj) {
                    const f32x4 o0 = r0[m][bj] + acc[ai][bj][m][0], o1 = r1[m][bj] + acc[ai][bj][m][1];
                    u32x4 w; w.x = cvt_pk_bf16(o0[0], o0[1]); w.y = cvt_pk_bf16(o0[2], o0[3]); w.z = cvt_pk_bf16(o1[0], o1[1]); w.w = cvt_pk_bf16(o1[2], o1[3]);
                    *(u32x4*)(hn + off + bj * HALF) = w;
                    if (WITH_SS) q += (o0[0] * o0[0] + o0[1] * o0[1]) + (o0[2] * o0[2] + o0[3] * o0[3]) + (o1[0] * o1[0] + o1[1] * o1[1]) + (o1[2] * o1[2] + o1[3] * o1[3]); }
                if (WITH_SS) { q += __shfl_xor(q, 16); q += __shfl_xor(q, 32); if (fq == 0) ss[(size_t)row * 32 + u.pn * 4 + wc] = q; } }
        }
    }
};


__device__ __forceinline__ float dpp_ror1(float x) { return __builtin_bit_cast(float, __builtin_amdgcn_update_dpp(0, __builtin_bit_cast(int, x), 0x121, 0xf, 0xf, false)); }
__device__ __forceinline__ float dpp_ror15(float x) { return __builtin_bit_cast(float, __builtin_amdgcn_update_dpp(0, __builtin_bit_cast(int, x), 0x12f, 0xf, 0xf, false)); }
struct EpiGLU {
    static constexpr bool PERM = true, AFTER_DRAIN = false;
    bf16_t* Z; float* EDGE; const float* cw; const float* cb; const float* ss; PG8_LAS float* ebuf;
    __device__ __forceinline__ void operator()(const f32x4 (&acc)[2][2][4][2], const Unit& u, int wr, int wc, int fr, int fq) const {
        constexpr int FFc = 5504;
        const int row0 = u.pm * BM + wr * 64 + fr;
        const int lcol = wc * 32 + 8 * fq;
        const int fcol = u.pn * 128 + lcol;
        float rs[2][4];
#pragma unroll
        for (int ai = 0; ai < 2; ++ai) {
            f32x4 t4[4];
#pragma unroll
            for (int m = 0; m < 4; ++m) { const f32x4* sp = (const f32x4*)(ss + (size_t)(row0 + ai * HALF + m * 16) * 32) + 2 * fq; t4[m] = sp[0] + sp[1]; }
#pragma unroll
            for (int m = 0; m < 4; ++m) { float tq = (t4[m][0] + t4[m][1]) + (t4[m][2] + t4[m][3]); tq += __shfl_xor(tq, 16); tq += __shfl_xor(tq, 32); rs[ai][m] = rsqrtf(tq * (1.0f / 2048.0f) + 1e-6f); }
        }
        {
            const f32x4 f00 = acc[0][0][0][0] * rs[0][0], f01 = acc[0][0][0][1] * rs[0][0], l00 = acc[0][0][3][0] * rs[0][3], l01 = acc[0][0][3][1] * rs[0][3];
            const f32x4 f10 = acc[1][0][0][0] * rs[1][0], f11 = acc[1][0][0][1] * rs[1][0], l10 = acc[1][0][3][0] * rs[1][3], l11 = acc[1][0][3][1] * rs[1][3];
            PG8_LAS float* e0 = ebuf + (wr * 2) * 128 + lcol;
            if (fr == 0) { *(PG8_LAS f32x4*)(e0) = f00; *(PG8_LAS f32x4*)(e0 + 4) = f01; *(PG8_LAS f32x4*)(e0 + 512) = f10; *(PG8_LAS f32x4*)(e0 + 516) = f11; }
            if (fr == 15) { *(PG8_LAS f32x4*)(e0 + 128) = l00; *(PG8_LAS f32x4*)(e0 + 132) = l01; *(PG8_LAS f32x4*)(e0 + 640) = l10; *(PG8_LAS f32x4*)(e0 + 644) = l11; }
            if (wr == 0 && fr < 2) { float* e = EDGE + ((size_t)u.pm * 6 + fr) * FFc + fcol;
                *(f32x4*)(e) = f00; *(f32x4*)(e + 4) = f01;
                if (fr == 0) { float* ev = EDGE + ((size_t)u.pm * 6 + 4) * FFc + fcol; *(f32x4*)(ev) = acc[0][1][0][0] * rs[0][0]; *(f32x4*)(ev + 4) = acc[0][1][0][1] * rs[0][0]; } }
            if (wr == 1 && fr >= 14) { float* e = EDGE + ((size_t)u.pm * 6 + 2 + (fr - 14)) * FFc + fcol;
                *(f32x4*)(e) = l10; *(f32x4*)(e + 4) = l11;
                if (fr == 15) { float* ev = EDGE + ((size_t)u.pm * 6 + 5) * FFc + fcol; *(f32x4*)(ev) = acc[1][1][3][0] * rs[1][3]; *(f32x4*)(ev + 4) = acc[1][1][3][1] * rs[1][3]; } }
        }
        asm volatile("s_waitcnt lgkmcnt(0)" ::: "memory"); __builtin_amdgcn_s_barrier(); asm volatile("" ::: "memory");
#pragma unroll
        for (int n = 0; n < 2; ++n) {
            const f32x4 w0 = *(const f32x4*)(cw + fcol + 4 * n), w1 = *(const f32x4*)(cw + FFc + fcol + 4 * n), w2 = *(const f32x4*)(cw + 2 * FFc + fcol + 4 * n), bb = *(const f32x4*)(cb + fcol + 4 * n);
#pragma unroll
            for (int ai = 0; ai < 2; ++ai) { const int blk = ai * 2 + wr;
#pragma unroll
                for (int m = 0; m < 4; ++m) {
                    const f32x4 zero4 = (f32x4){0.f, 0.f, 0.f, 0.f};
                    const f32x4 Ac = acc[ai][0][m][n] * rs[ai][m];
                    f32x4 pvs, nxs;
                    if (m > 0) { const f32x4 Ap = acc[ai][0][m > 0 ? m - 1 : 0][n] * rs[ai][m > 0 ? m - 1 : 0];
#pragma unroll
                        for (int e = 0; e < 4; ++e) pvs[e] = dpp_ror1(Ap[e]); }
                    else pvs = (blk > 0) ? *(const PG8_LAS f32x4*)(ebuf + ((blk - 1) * 2 + 1) * 128 + lcol + 4 * n) : zero4;
                    if (m < 3) { const f32x4 An = acc[ai][0][m < 3 ? m + 1 : 3][n] * rs[ai][m < 3 ? m + 1 : 3];
#pragma unroll
                        for (int e = 0; e < 4; ++e) nxs[e] = dpp_ror15(An[e]); }
                    else nxs = (blk < 3) ? *(const PG8_LAS f32x4*)(ebuf + ((blk + 1) * 2 + 0) * 128 + lcol + 4 * n) : zero4;
                    f32x4 pv, nx;
#pragma unroll
                    for (int e = 0; e < 4; ++e) { const float r1 = dpp_ror1(Ac[e]), l1 = dpp_ror15(Ac[e]); pv[e] = (fr == 0) ? pvs[e] : r1; nx[e] = (fr == 15) ? nxs[e] : l1; }
                    const f32x4 c = bb + w0 * pv + w1 * Ac + w2 * nx;
                    const f32x4 vv = acc[ai][1][m][n] * rs[ai][m];
                    const f32x2 g0 = gelu_pk((f32x2){c[0], c[1]}), g1 = gelu_pk((f32x2){c[2], c[3]});
                    typedef unsigned u32x2e __attribute__((ext_vector_type(2)));
                    u32x2e w; w.x = cvt_pk_bf16(g0.x * vv[0], g0.y * vv[1]); w.y = cvt_pk_bf16(g1.x * vv[2], g1.y * vv[3]);
                    *(u32x2e*)(Z + (size_t)(row0 + ai * HALF + m * 16) * FFc + fcol + 4 * n) = w;
                    __builtin_amdgcn_sched_barrier(0);
                }
            }
        }
    }
};

template <class Epi, class Sched, bool ALIGN_EPI = false, bool SP2 = false>
__device__ __forceinline__ void gemm_phase(PG8_LAS unsigned char* lds, const Gemm g, const Sched& S, const Epi& E) {
    int tid_ = threadIdx.x; asm volatile("" : "+v"(tid_));
    const int tid = tid_, wid = __builtin_amdgcn_readfirstlane(tid >> 6), lane = tid & 63, wr = wid >> 2, wc = wid & 3, fr = lane & 15, fq = lane >> 4;
    const int K = g.K, nt = K / BK;
    unsigned voffA[2], voffB[2];
#pragma unroll
    for (int i = 0; i < 2; ++i) { int R, C; stage_rc(tid * 16 + i * 8192, R, C); const int Rb = Epi::PERM ? ((R & ~31) + perm32(R & 31)) : R;
        voffA[i] = (unsigned)(R * K + C) * 2u; voffB[i] = (unsigned)(Rb * K + C) * 2u; }
    const size_t kstep = (size_t)(BK * 2);
    const size_t hstep = (size_t)HALF * K * 2;
    const size_t tstep = 2 * hstep;
    const unsigned ldsw = (unsigned)wid * 1024u;
    const int aoff = lds_byte(wr * 64 + fr, fq * 8), boff = lds_byte(wc * 32 + fr, fq * 8);
#define PG8_SA(b, h) (((b) * 2 + (h)) * HTB)
#define PG8_SB(b, h) ((4 + (b) * 2 + (h)) * HTB)
#define PG8_STAGE(bufoff, gbase, voff) do { _Pragma("unroll") for (int _i = 0; _i < 2; ++_i) \
        __builtin_amdgcn_global_load_lds((const unsigned*)((const char*)(gbase) + (voff)[_i]), (PG8_LAS unsigned*)(lds + (bufoff) + ldsw + _i * 8192), 16, 0, 0); } while (0)
#define PG8_LDA(dst, b, h) do { _Pragma("unroll") for (int m = 0; m < 4; ++m) _Pragma("unroll") for (int k = 0; k < 2; ++k) dst[m][k] = *(const PG8_LAS bf16x8*)(lds + PG8_SA(b, h) + aoff + m * 2048 + k * 1024); } while (0)
#define PG8_LDB(dst, b, h) do { _Pragma("unroll") for (int n = 0; n < 2; ++n) _Pragma("unroll") for (int k = 0; k < 2; ++k) dst[n][k] = *(const PG8_LAS bf16x8*)(lds + PG8_SB(b, h) + boff + n * 2048 + k * 1024); } while (0)
#define PG8_MMA(ai, bj, At, Bt) do { __builtin_amdgcn_s_setprio(1); _Pragma("unroll") for (int m = 0; m < 4; ++m) _Pragma("unroll") for (int n = 0; n < 2; ++n) _Pragma("unroll") for (int k = 0; k < 2; ++k) \
        acc[ai][bj][m][n] = __builtin_amdgcn_mfma_f32_16x16x32_bf16(Bt[n][k], At[m][k], acc[ai][bj][m][n], 0, 0, 0); __builtin_amdgcn_s_setprio(0); } while (0)
#define PG8_WAIT_V(n) asm volatile("s_waitcnt vmcnt(" #n ")" ::: "memory")
#define PG8_WAIT_L(n) asm volatile("s_waitcnt lgkmcnt(" #n ")" ::: "memory")
#define PG8_BAR __builtin_amdgcn_s_barrier()
#define PG8_SCHED __builtin_amdgcn_sched_barrier(0)
    Unit cur, nxt; int ui = 0;
    if (!S.next(0, cur)) return;
    f32x4 acc[2][2][4][2];
#pragma unroll
    for (int a = 0; a < 2; ++a)
#pragma unroll
        for (int b = 0; b < 2; ++b)
#pragma unroll
            for (int m = 0; m < 4; ++m)
#pragma unroll
                for (int n = 0; n < 2; ++n) acc[a][b][m][n] = (f32x4){0.f, 0.f, 0.f, 0.f};
    bf16x8 At[4][2], B0[2][2], B1[2][2];
    const char* cA = (const char*)g.A + (size_t)cur.pm * tstep; const char* cB = (const char*)g.Bt + (size_t)cur.pn * tstep;
    S.a_ready(cur);
    if constexpr (SP2) {
        PG8_STAGE(PG8_SB(0, 0), cB, voffB); PG8_STAGE(PG8_SB(0, 1), cB + hstep, voffB); PG8_STAGE(PG8_SA(0, 0), cA, voffA); PG8_STAGE(PG8_SA(0, 1), cA + hstep, voffA);
        if (wr == 1) PG8_BAR;
        PG8_WAIT_V(2); PG8_BAR;
        PG8_STAGE(PG8_SB(1, 0), cB + kstep, voffB); PG8_STAGE(PG8_SA(1, 0), cA + kstep, voffA); PG8_STAGE(PG8_SB(1, 1), cB + hstep + kstep, voffB);
        PG8_WAIT_V(6); PG8_BAR;
    } else {
        PG8_STAGE(PG8_SB(0, 0), cB, voffB); PG8_STAGE(PG8_SA(0, 0), cA, voffA); PG8_STAGE(PG8_SB(0, 1), cB + hstep, voffB); PG8_STAGE(PG8_SA(0, 1), cA + hstep, voffA);
        if (wr == 1) PG8_BAR;
        PG8_WAIT_V(4); PG8_BAR;
        PG8_STAGE(PG8_SB(1, 0), cB + kstep, voffB); PG8_STAGE(PG8_SA(1, 0), cA + kstep, voffA); PG8_STAGE(PG8_SB(1, 1), cB + hstep + kstep, voffB);
        PG8_WAIT_V(6); PG8_BAR;
    }
    for (;;) {
        const bool has_next = S.next(ui + 1, nxt);
        const char* nA = has_next ? (const char*)g.A + (size_t)nxt.pm * tstep : cA; const char* nB = has_next ? (const char*)g.Bt + (size_t)nxt.pn * tstep : cB;
        for (int t = 0; t < nt; t += 2) {
            const bool last = (t == nt - 2);
            const char* a1 = cA + (size_t)(t + 1) * kstep;
            const char* a2 = last ? nA : cA + (size_t)(t + 2) * kstep; const char* b2 = last ? nB : cB + (size_t)(t + 2) * kstep;
            const char* a3 = a2 + kstep; const char* b3 = b2 + kstep;
            if (last && has_next) S.a_ready(nxt);
            if constexpr (SP2) {
            PG8_LDB(B0, 0, 0); PG8_LDB(B1, 0, 1); PG8_SCHED; PG8_LDA(At, 0, 0); PG8_STAGE(PG8_SA(1, 1), a1 + hstep, voffA);
            PG8_WAIT_V(8); PG8_WAIT_L(0); PG8_BAR; PG8_MMA(0, 0, At, B0); PG8_MMA(0, 1, At, B1); PG8_BAR; PG8_SCHED;
            PG8_LDA(At, 0, 1); PG8_STAGE(PG8_SB(0, 0), b2, voffB); PG8_STAGE(PG8_SB(0, 1), b2 + hstep, voffB); PG8_STAGE(PG8_SA(0, 0), a2, voffA);
            PG8_WAIT_V(8); PG8_WAIT_L(0); PG8_BAR; PG8_MMA(1, 0, At, B0); PG8_MMA(1, 1, At, B1); PG8_BAR; PG8_SCHED;
            PG8_LDB(B0, 1, 0); PG8_LDB(B1, 1, 1); PG8_SCHED; PG8_LDA(At, 1, 0); PG8_STAGE(PG8_SA(0, 1), a2 + hstep, voffA);
            PG8_WAIT_V(8); PG8_WAIT_L(0); PG8_BAR; PG8_MMA(0, 0, At, B0); PG8_MMA(0, 1, At, B1); PG8_BAR; PG8_SCHED;
            PG8_LDA(At, 1, 1); PG8_STAGE(PG8_SB(1, 0), b3, voffB); PG8_STAGE(PG8_SB(1, 1), b3 + hstep, voffB); PG8_STAGE(PG8_SA(1, 0), a3, voffA);
            PG8_WAIT_V(8); PG8_WAIT_L(0); PG8_BAR; PG8_MMA(1, 0, At, B0); PG8_MMA(1, 1, At, B1); PG8_BAR; PG8_SCHED;
            } else {
            PG8_LDB(B0, 0, 0); PG8_SCHED; PG8_LDA(At, 0, 0); PG8_STAGE(PG8_SA(1, 1), a1 + hstep, voffA);
            PG8_WAIT_L(8); PG8_BAR; PG8_WAIT_L(0); PG8_MMA(0, 0, At, B0); PG8_BAR; PG8_SCHED;
            PG8_LDB(B1, 0, 1); PG8_STAGE(PG8_SB(0, 0), b2, voffB);
            PG8_BAR; PG8_WAIT_L(0); PG8_MMA(0, 1, At, B1); PG8_BAR;
            PG8_LDA(At, 0, 1); PG8_STAGE(PG8_SA(0, 0), a2, voffA);
            PG8_BAR; PG8_WAIT_L(0); PG8_MMA(1, 0, At, B0); PG8_BAR; PG8_SCHED;
            PG8_STAGE(PG8_SB(0, 1), b2 + hstep, voffB);
            PG8_WAIT_V(6); PG8_BAR; PG8_MMA(1, 1, At, B1); PG8_BAR;
            PG8_LDB(B0, 1, 0); PG8_SCHED; PG8_LDA(At, 1, 0); PG8_STAGE(PG8_SA(0, 1), a2 + hstep, voffA);
            PG8_WAIT_L(8); PG8_BAR; PG8_WAIT_L(0); PG8_MMA(0, 0, At, B0); PG8_BAR; PG8_SCHED;
            PG8_LDB(B1, 1, 1); PG8_STAGE(PG8_SB(1, 0), b3, voffB);
            PG8_BAR; PG8_WAIT_L(0); PG8_MMA(0, 1, At, B1); PG8_BAR;
            PG8_LDA(At, 1, 1); PG8_STAGE(PG8_SA(1, 0), a3, voffA);
            PG8_BAR; PG8_WAIT_L(0); PG8_MMA(1, 0, At, B0); PG8_BAR; PG8_SCHED;
            PG8_STAGE(PG8_SB(1, 1), b3 + hstep, voffB);
            PG8_WAIT_V(6); PG8_BAR; PG8_MMA(1, 1, At, B1); PG8_BAR;
            }
        }
        if constexpr (ALIGN_EPI) { if (wr == 0) PG8_BAR; }
        if constexpr (!Epi::AFTER_DRAIN) { E(acc, cur, wr, wc, fr, fq); S.done(cur); }
        if (!has_next) break;
#pragma unroll
        for (int a = 0; a < 2; ++a)
#pragma unroll
            for (int b = 0; b < 2; ++b)
#pragma unroll
                for (int m = 0; m < 4; ++m)
#pragma unroll
                    for (int n = 0; n < 2; ++n) acc[a][b][m][n] = (f32x4){0.f, 0.f, 0.f, 0.f};
        cur = nxt; cA = nA; cB = nB; ++ui;
        if constexpr (ALIGN_EPI) { if (wr == 1) PG8_BAR; }
    }
    PG8_WAIT_V(0);
    if constexpr (!ALIGN_EPI) { if (wr == 0) PG8_BAR; }
    PG8_BAR;
    if constexpr (Epi::AFTER_DRAIN) { E.fused(acc, cur, wr, wc, fr, fq, lds, wid, lane); S.done(cur); }
#undef PG8_SA
#undef PG8_SB
#undef PG8_STAGE
#undef PG8_LDA
#undef PG8_LDB
#undef PG8_MMA
#undef PG8_WAIT_V
#undef PG8_WAIT_L
#undef PG8_BAR
#undef PG8_SCHED
}
}

constexpr int T = 8192, D = 2048, SEQ = 2048;
constexpr int N_IN0 = 6176, N_IN0P = 6400, LDP0 = 6144;
constexpr int N_IN1 = 10240;
constexpr int FF = 5504, FF2 = 11008;
constexpr float EPS = 1e-6f;
constexpr size_t MiB = 1u << 20;
constexpr size_t WS_WIN0 = 1 * MiB;
constexpr size_t WS_WOUT0 = WS_WIN0 + 25 * MiB;
constexpr size_t WS_WIN1 = WS_WOUT0 + 8 * MiB;
constexpr size_t WS_WOUT1 = WS_WIN1 + 40 * MiB;
constexpr size_t WS_WUP = WS_WOUT1 + 8 * MiB;
constexpr size_t WS_WDN = WS_WUP + 86 * MiB;
constexpr size_t WS_HN = WS_WDN + 43 * MiB;
constexpr size_t WS_H = WS_HN + 32 * MiB;
constexpr size_t WS_G0 = WS_H + 64 * MiB;
constexpr size_t WS_PU = WS_G0 + 1 * MiB;
constexpr size_t WS_YF = WS_PU + 172 * MiB;
constexpr size_t WS_YB = WS_YF + 32 * MiB;
constexpr size_t WS_Y = WS_YB + 32 * MiB;
constexpr size_t WS_Z = WS_Y + 32 * MiB;
constexpr size_t WS_END = WS_Z + 86 * MiB;
constexpr size_t WS_SS = WS_END;
constexpr size_t WS_EDGE = WS_END + 4 * MiB;
constexpr size_t WS_END2 = WS_EDGE + 5 * MiB;
constexpr int UP_TAIL = (32 * (FF2 / 256)) % 256;
constexpr int LDS_BYTES = 147456;

#define LAS __attribute__((address_space(3)))
typedef LAS unsigned char* ldsp;
typedef unsigned short bf16;
typedef float f32x4 __attribute__((ext_vector_type(4)));
typedef short bf16x8 __attribute__((ext_vector_type(8)));
typedef unsigned u32x4 __attribute__((ext_vector_type(4)));
typedef unsigned u32x2 __attribute__((ext_vector_type(2)));

__device__ __forceinline__ float bf2f(unsigned b) { return __builtin_bit_cast(float, b << 16); }
typedef __bf16 bf16x2_t __attribute__((ext_vector_type(2)));
typedef float f32x2_t __attribute__((ext_vector_type(2)));
__device__ __forceinline__ unsigned pk2(float lo, float hi) { f32x2_t f = {lo, hi}; bf16x2_t v = __builtin_convertvector(f, bf16x2_t); return __builtin_bit_cast(unsigned, v); }
__device__ __forceinline__ float wave_sum(float v) {
#pragma unroll
    for (int o = 1; o < 64; o <<= 1) v += __shfl_xor(v, o);
    return v;
}
#define LDS_WAIT() asm volatile("s_waitcnt lgkmcnt(0)" ::: "memory")

struct P0Mat { const float* W; bf16* WT; const float* gk; int K, N; bool glu; int ld = 0, noff = 0; };
__device__ __forceinline__ void p0_load(const P0Mat m, int item, int lane, float (&wv)[32]) {
    const int nblk = m.N / 32, kb = item / nblk, nb = item % nblk, k0 = 64 * kb, n0 = m.noff + 32 * nb, ld = m.ld ? m.ld : m.N;
    const float* wp = m.W + (size_t)(k0 + (lane >> 5)) * ld + n0 + (lane & 31);
#pragma unroll
    for (int i = 0; i < 32; ++i) wv[i] = __builtin_nontemporal_load(wp + (size_t)(2 * i) * ld);
}
__device__ __forceinline__ void p0_finish(const P0Mat m, int item, int lane, const float (&wv)[32], LAS float* scr) {
    const int nblk = m.N / 32, kb = item / nblk, nb = item % nblk, k0 = 64 * kb, n0 = m.noff + 32 * nb;
#pragma unroll
    for (int i = 0; i < 32; ++i) scr[(2 * i + (lane >> 5)) * 33 + (lane & 31)] = wv[i];
    LDS_WAIT(); asm volatile("" ::: "memory");
    const int c = lane & 7;
    float g8[8];
#pragma unroll
    for (int i = 0; i < 8; ++i) g8[i] = m.gk ? m.gk[k0 + 8 * c + i] : 1.0f;
#pragma unroll
    for (int j = 0; j < 4; ++j) { const int n = (lane >> 3) + 8 * j; const LAS float* s = scr + (8 * c) * 33 + n;
        u32x4 o; o.x = pk2(s[0 * 33] * g8[0], s[1 * 33] * g8[1]); o.y = pk2(s[2 * 33] * g8[2], s[3 * 33] * g8[3]); o.z = pk2(s[4 * 33] * g8[4], s[5 * 33] * g8[5]); o.w = pk2(s[6 * 33] * g8[6], s[7 * 33] * g8[7]);
        const int d0 = !m.glu ? n0 : (n0 < FF ? ((n0 >> 7) * 256 + (n0 & 127)) : ((((n0 - FF) >> 7) * 256) + 128 + ((n0 - FF) & 127)));
        *(u32x4*)(m.WT + (size_t)(d0 + n) * m.K + k0 + 8 * c) = o; }
    LDS_WAIT(); asm volatile("" ::: "memory");
}
__device__ __forceinline__ void p0_convert(const P0Mat m, int count, int first, int stride, int lane, LAS float* scr) {
    if (first >= count) return;
    float wa[32], wb[32];
    p0_load(m, first, lane, wa);
#pragma unroll 1
    for (int it = first; it < count; it += 2 * stride) {
        const bool h1 = it + stride < count, h2 = it + 2 * stride < count;
        if (h1) p0_load(m, it + stride, lane, wb);
        p0_finish(m, it, lane, wa, scr);
        if (h2) p0_load(m, it + 2 * stride, lane, wa);
        if (h1) p0_finish(m, it + stride, lane, wb, scr);
    }
}
__device__ __forceinline__ void p0_transpose_item(const float* W, int K, int N, bf16* WT, LAS float* scr, int item, int lane, const float* gk = nullptr, bool glu = false) {
    const P0Mat m{W, WT, gk, K, N, glu}; float wv[32]; p0_load(m, item, lane, wv); p0_finish(m, item, lane, wv, scr);
}

__device__ __forceinline__ void unpack8(const u32x4 w, float (&o)[8]) {
    o[0] = bf2f(w.x & 0xffffu); o[1] = bf2f(w.x >> 16); o[2] = bf2f(w.y & 0xffffu); o[3] = bf2f(w.y >> 16);
    o[4] = bf2f(w.z & 0xffffu); o[5] = bf2f(w.z >> 16); o[6] = bf2f(w.w & 0xffffu); o[7] = bf2f(w.w >> 16);
}
__device__ __forceinline__ void rms_rows_final(const bf16* src, const float* g, float* dstf, int gw, int NGW, int lane) {
    for (int row = gw; row < T; row += NGW) {
        const u32x4* xr = (const u32x4*)(src + (size_t)row * D) + lane;
        float v[4][8]; float ss = 0.f;
#pragma unroll
        for (int j = 0; j < 4; ++j) { unpack8(xr[64 * j], v[j]);
#pragma unroll
            for (int e = 0; e < 8; ++e) ss += v[j][e] * v[j][e]; }
        const float r = rsqrtf(wave_sum(ss) * (1.0f / D) + EPS);
#pragma unroll
        for (int j = 0; j < 4; ++j) { const int c = (lane + 64 * j) * 8; const f32x4 g0 = *(const f32x4*)(g + c), g1 = *(const f32x4*)(g + c + 4);
            f32x4 o0, o1;
#pragma unroll
            for (int e = 0; e < 4; ++e) { o0[e] = v[j][e] * r * g0[e]; o1[e] = v[j][4 + e] * r * g1[e]; }
            *(f32x4*)(dstf + (size_t)row * D + c) = o0; *(f32x4*)(dstf + (size_t)row * D + c + 4) = o1; }
    }
}
__device__ __forceinline__ void cast_rows(const float* src, bf16* dstb, float* ss, int gw, int NGW, int lane) {
    for (int row = gw; row < T; row += NGW) {
        const f32x4* xr = (const f32x4*)(src + (size_t)row * D) + lane;
        f32x4 v[8]; float q = 0.f;
#pragma unroll
        for (int j = 0; j < 8; ++j) { v[j] = xr[64 * j]; q += (v[j].x * v[j].x + v[j].y * v[j].y) + (v[j].z * v[j].z + v[j].w * v[j].w); }
        q = wave_sum(q);
#pragma unroll
        for (int j = 0; j < 8; ++j) { u32x2 w; w.x = pk2(v[j].x, v[j].y); w.y = pk2(v[j].z, v[j].w); ((u32x2*)(dstb + (size_t)row * D))[lane + 64 * j] = w; }
        if (lane < 32) ss[(size_t)row * 32 + lane] = (lane == 0) ? q : 0.f;
    }
}

template <int HD, bool SILU>
__device__ __forceinline__ void gatenorm(const bf16* __restrict__ YF, const bf16* __restrict__ YB, const bf16* __restrict__ gate, int ldg, const float* __restrict__ hg, bf16* __restrict__ Y, int gw, int NGW, int lane) {
    constexpr int NB = 4;
    for (int it0 = gw * NB; it0 < T * 8; it0 += NGW * NB) {
        u32x2 a[NB], b[NB], gq[NB]; f32x4 hgv[NB];
#pragma unroll
        for (int k = 0; k < NB; ++k) { const int item = it0 + k, tok = item >> 3, col = (item & 7) * 256 + lane * 4;
            a[k] = *(const u32x2*)(YF + (size_t)tok * D + col); b[k] = *(const u32x2*)(YB + (size_t)tok * D + col); gq[k] = *(const u32x2*)(gate + (size_t)tok * ldg + col); hgv[k] = *(const f32x4*)(hg + col); }
#pragma unroll
        for (int k = 0; k < NB; ++k) { const int item = it0 + k, tok = item >> 3, col = (item & 7) * 256 + lane * 4;
            float y[4] = { bf2f(a[k].x & 0xffffu) + bf2f(b[k].x & 0xffffu), bf2f(a[k].x >> 16) + bf2f(b[k].x >> 16), bf2f(a[k].y & 0xffffu) + bf2f(b[k].y & 0xffffu), bf2f(a[k].y >> 16) + bf2f(b[k].y >> 16) };
            float gt[4] = { bf2f(gq[k].x & 0xffffu), bf2f(gq[k].x >> 16), bf2f(gq[k].y & 0xffffu), bf2f(gq[k].y >> 16) };
            float ss = (y[0] * y[0] + y[1] * y[1]) + (y[2] * y[2] + y[3] * y[3]);
#pragma unroll
            for (int o = 1; o < HD / 4; o <<= 1) ss += __shfl_xor(ss, o);
            const float r = rsqrtf(ss * (1.0f / HD) + EPS);
            float o4[4];
#pragma unroll
            for (int e = 0; e < 4; ++e) { const float sg = __builtin_amdgcn_rcpf(1.0f + __expf(-gt[e])); const float act = SILU ? gt[e] * sg : sg; o4[e] = y[e] * r * hgv[k][e] * act; }
            u32x2 w; w.x = pk2(o4[0], o4[1]); w.y = pk2(o4[2], o4[3]);
            *(u32x2*)(Y + (size_t)tok * D + col) = w; }
    }
}


__device__ __forceinline__ void glu_fixup(const float* __restrict__ EDGE, const float* __restrict__ cw, const float* __restrict__ cb, bf16* __restrict__ Z, int pm) {
    for (int v8 = threadIdx.x; v8 < 2 * (FF / 8); v8 += 512) {
        const int which = v8 / (FF / 8), c8 = (v8 % (FF / 8)) * 8;
        if (which == 0 ? ((pm & 7) == 0) : ((pm & 7) == 7)) continue;
        const float* pp = which == 0 ? EDGE + ((size_t)(pm - 1) * 6 + 3) * FF + c8 : EDGE + ((size_t)pm * 6 + 2) * FF + c8;
        const float* pc = which == 0 ? EDGE + ((size_t)pm * 6 + 0) * FF + c8 : EDGE + ((size_t)pm * 6 + 3) * FF + c8;
        const float* pn = which == 0 ? EDGE + ((size_t)pm * 6 + 1) * FF + c8 : EDGE + ((size_t)(pm + 1) * 6 + 0) * FF + c8;
        const float* pv = EDGE + ((size_t)pm * 6 + 4 + which) * FF + c8;
        float z[8];
#pragma unroll
        for (int h = 0; h < 2; ++h) { const f32x4 a0 = *(const f32x4*)(pp + 4 * h), a1 = *(const f32x4*)(pc + 4 * h), a2 = *(const f32x4*)(pn + 4 * h), vv = *(const f32x4*)(pv + 4 * h);
            const f32x4 k0 = *(const f32x4*)(cw + c8 + 4 * h), k1 = *(const f32x4*)(cw + FF + c8 + 4 * h), k2 = *(const f32x4*)(cw + 2 * FF + c8 + 4 * h), bb = *(const f32x4*)(cb + c8 + 4 * h);
            const f32x4 c = bb + k0 * a0 + k1 * a1 + k2 * a2;
            const pg8::f32x2 g0 = pg8::gelu_pk((pg8::f32x2){c[0], c[1]}), g1 = pg8::gelu_pk((pg8::f32x2){c[2], c[3]});
            z[4 * h] = g0.x * vv[0]; z[4 * h + 1] = g0.y * vv[1]; z[4 * h + 2] = g1.x * vv[2]; z[4 * h + 3] = g1.y * vv[3]; }
        u32x4 w; w.x = pk2(z[0], z[1]); w.y = pk2(z[2], z[3]); w.z = pk2(z[4], z[5]); w.w = pk2(z[6], z[7]);
        *(u32x4*)(Z + (size_t)(pm * 256 + (which ? 255 : 0)) * FF + c8) = w;
    }
    asm volatile("s_waitcnt vmcnt(0)" ::: "memory"); __syncthreads();
}

template <int KS> __device__ __forceinline__ void ld_frag(bf16x8 (&f)[KS], ldsp X, int xs, int r0, int fr, int fq) {
    ldsp p = X + (r0 + fr) * xs + fq * 16;
#pragma unroll
    for (int k = 0; k < KS; ++k) f[k] = *(const LAS bf16x8*)(p + k * 64);
}
template <int KS> __device__ __forceinline__ f32x4 mma_frag(const bf16x8 (&a)[KS], const bf16x8 (&b)[KS], f32x4 acc) {
#pragma unroll
    for (int k = 0; k < KS; ++k) acc = __builtin_amdgcn_mfma_f32_16x16x32_bf16(a[k], b[k], acc, 0, 0, 0);
    return acc;
}
constexpr int QS = 272, TS = 144;


__device__ __forceinline__ void gate_gemm(ldsp lds, const bf16* HN, const bf16* Wg, const float* ss, const float* bias, float* G, int blk, int nblk) {
    const int tid = threadIdx.x, lane = tid & 63, wid = __builtin_amdgcn_readfirstlane(tid >> 6), fr = lane & 15, fq = lane >> 4;
    LAS float* red = (LAS float*)lds;
    for (int rb = blk; rb < T / 32; rb += nblk) {
        const int R0 = rb * 32, k0 = wid * 256;
        f32x4 acc[2][2];
#pragma unroll
        for (int a = 0; a < 2; ++a)
#pragma unroll
            for (int b = 0; b < 2; ++b) acc[a][b] = (f32x4){0.f, 0.f, 0.f, 0.f};
        bf16x8 fa[2][8], fb[2][8];
#pragma unroll
        for (int t = 0; t < 2; ++t)
#pragma unroll
            for (int k = 0; k < 8; ++k) { fa[t][k] = *(const bf16x8*)(HN + (size_t)(R0 + t * 16 + fr) * D + k0 + k * 32 + fq * 8); fb[t][k] = *(const bf16x8*)(Wg + (size_t)(t * 16 + fr) * D + k0 + k * 32 + fq * 8); }
#pragma unroll
        for (int k = 0; k < 8; ++k)
#pragma unroll
            for (int a = 0; a < 2; ++a)
#pragma unroll
                for (int b = 0; b < 2; ++b) acc[a][b] = __builtin_amdgcn_mfma_f32_16x16x32_bf16(fa[a][k], fb[b][k], acc[a][b], 0, 0, 0);
        __syncthreads();
#pragma unroll
        for (int a = 0; a < 2; ++a)
#pragma unroll
            for (int b = 0; b < 2; ++b)
#pragma unroll
                for (int j = 0; j < 4; ++j) red[(wid * 32 + a * 16 + fq * 4 + j) * 33 + b * 16 + fr] = acc[a][b][j];
        __syncthreads();
#pragma unroll
        for (int e = 0; e < 2; ++e) { const int o = tid + 512 * e, row = o >> 5, col = o & 31; float v = 0.f;
#pragma unroll
            for (int w = 0; w < 8; ++w) v += red[(w * 32 + row) * 33 + col];
            const float rs = rsqrtf(ss[(size_t)(R0 + row) * 32] * (1.0f / 2048.0f) + 1e-6f);
            G[(size_t)(R0 + row) * 32 + col] = v * rs + bias[col]; }
    }
    __syncthreads();
}

__device__ __forceinline__ void mlstm_phase(ldsp lds, const bf16* P, const float* G, bf16* YF, bf16* YB, int vcu, int G_) {
    const int tid = threadIdx.x, lane = tid & 63, wid = __builtin_amdgcn_readfirstlane(tid >> 6), fr = lane & 15, fq = lane >> 4;
    ldsp sQ = lds, sK = sQ + 64 * QS, sKt = sK + 64 * QS, sVt = sKt + 128 * TS, sP = sVt + 80 * TS, sC = sP + 64 * TS;
    LAS float* sDen = (LAS float*)(sC + 80 * QS);
    LAS float* sPre = sDen + 64;
    LAS float* sCh = sPre + 32 * 192;
    LAS float* sMst = sCh + 64;
    for (int unit = vcu; unit < 256; unit += G_) {
        const int slice = unit & 3, dir = (unit >> 2) & 1, h = (unit >> 3) & 7, b = unit >> 6;
        bf16* Yo = dir ? YB : YF;
#define ML_TOK(ci, i) (b * SEQ + (dir ? (SEQ - 1 - ((ci) * 64 + (i))) : ((ci) * 64 + (i))))
        __syncthreads();
        for (int i = tid; i < 80 * QS / 4; i += 512) ((LAS unsigned*)sC)[i] = 0u;
        for (int i = tid; i < 16 * TS / 4; i += 512) ((LAS unsigned*)(sVt + 64 * TS))[i] = (i < TS / 4) ? 0x3f803f80u : 0u;
        {
            float gi[4], gf[4];
#pragma unroll
            for (int c = 0; c < 4; ++c) { const float* gp = G + (size_t)ML_TOK(wid * 4 + c, lane) * 32 + dir * 16 + h; gi[c] = gp[0]; gf[c] = gp[8]; }
#pragma unroll
            for (int c = 0; c < 4; ++c) {
                const float lf = (gf[c] >= 0.f) ? -log1pf(__expf(-gf[c])) : gf[c] - log1pf(__expf(gf[c]));
                float bc = lf;
#pragma unroll
                for (int o = 1; o < 64; o <<= 1) { const float t = __shfl_up(bc, o); if (lane >= o) bc += t; }
                const float u = gi[c] - bc; float pm = u;
#pragma unroll
                for (int o = 1; o < 64; o <<= 1) { const float t = __shfl_up(pm, o); if (lane >= o) pm = fmaxf(pm, t); }
                LAS float* pp = sPre + (wid * 4 + c) * 192;
                pp[lane] = bc; pp[64 + lane] = u; pp[128 + lane] = pm;
                if (lane == 63) { sCh[(wid * 4 + c) * 2] = bc; sCh[(wid * 4 + c) * 2 + 1] = pm; }
            }
        }
        __syncthreads();
        if (wid == 0) { float m = 0.f;
#pragma unroll 1
            for (int c = 0; c < 32; ++c) { if (lane == 0) sMst[c] = m; const float gt = sCh[2 * c], p63 = sCh[2 * c + 1]; m = gt + fmaxf(m, p63); } }
        f32x4 CT[5];
#pragma unroll
        for (int n = 0; n < 5; ++n) CT[n] = (f32x4){0.f, 0.f, 0.f, 0.f};
        u32x4 rq[2], rk[2]; unsigned rv[8];
#define ML_LOAD(ci) do { \
            _Pragma("unroll") for (int j = 0; j < 2; ++j) { const int id = tid + 512 * j, row = id >> 4, c16 = id & 15; const bf16* rp = P + (size_t)ML_TOK(ci, row) * LDP0 + h * 128 + c16 * 8; \
                rq[j] = *(const u32x4*)rp; rk[j] = *(const u32x4*)(rp + 1024); } \
            _Pragma("unroll") for (int e = 0; e < 8; ++e) rv[e] = P[(size_t)ML_TOK(ci, wid * 8 + e) * LDP0 + 2048 + h * 256 + slice * 64 + lane]; } while (0)
        ML_LOAD(0);
#pragma unroll 1
        for (int ci = 0; ci < 32; ++ci) {
            const LAS float* pp = sPre + ci * 192;
#pragma unroll
            for (int j = 0; j < 2; ++j) { const int id = tid + 512 * j, row = id >> 4, c16 = id & 15; *(LAS u32x4*)(sQ + row * QS + c16 * 16) = rq[j]; *(LAS u32x4*)(sK + row * QS + c16 * 16) = rk[j]; }
            { u32x4 w; w.x = rv[0] | (rv[1] << 16); w.y = rv[2] | (rv[3] << 16); w.z = rv[4] | (rv[5] << 16); w.w = rv[6] | (rv[7] << 16); *(LAS u32x4*)(sVt + lane * TS + wid * 16) = w; }
            if (ci + 1 < 32) ML_LOAD(ci + 1);
            __syncthreads();
            const float m_st = sMst[ci], mrel = fmaxf(m_st, sCh[2 * ci + 1]);
            const int w3 = wid & 3, mt0 = wid >> 2, mt1 = mt0 + 2;
            f32x4 acc[3];
            {
                bf16x8 fK[4], fa0[4], fa1[4];
                ld_frag<4>(fK, sK, QS, w3 * 16, fr, fq);
                ld_frag<4>(fa0, sQ, QS, mt0 * 16, fr, fq); ld_frag<4>(fa1, sQ, QS, mt1 * 16, fr, fq);
                const float cc = pp[64 + w3 * 16 + fr];
                const f32x4 pmA = *(const LAS f32x4*)(pp + 128 + mt0 * 16 + fq * 4), pmB = *(const LAS f32x4*)(pp + 128 + mt1 * 16 + fq * 4), pmC = *(const LAS f32x4*)(pp + 128 + w3 * 16 + fq * 4);
                const f32x4 u0 = *(const LAS f32x4*)(pp + 64 + wid * 8), u1 = *(const LAS f32x4*)(pp + 64 + wid * 8 + 4);
                unsigned kk[8];
#pragma unroll
                for (int e = 0; e < 8; ++e) kk[e] = *(const LAS unsigned*)(sK + (wid * 8 + e) * QS + lane * 4);
                const f32x4 z4 = (f32x4){0.f, 0.f, 0.f, 0.f};
                f32x4 s0 = z4, s1 = z4;
                if (w3 <= mt0) s0 = mma_frag<4>(fa0, fK, s0);
                s1 = mma_frag<4>(fa1, fK, s1);
                { bf16x8 fQ[4], fb0[4], fb1[4];
                  ld_frag<4>(fQ, sQ, QS, w3 * 16, fr, fq); ld_frag<4>(fb0, sC, QS, mt0 * 16, fr, fq); ld_frag<4>(fb1, sC, QS, mt1 * 16, fr, fq);
                  acc[0] = mma_frag<4>(fQ, fb0, z4); acc[1] = mma_frag<4>(fQ, fb1, z4); acc[2] = z4;
                  if (wid < 4) { bf16x8 fb2[4]; ld_frag<4>(fb2, sC, QS, 64, fr, fq); acc[2] = mma_frag<4>(fQ, fb2, z4); } }
                const int scol = w3 * 16 + fr;
#pragma unroll
                for (int j = 0; j < 4; ++j) { const int t0 = mt0 * 16 + fq * 4 + j, t1 = mt1 * 16 + fq * 4 + j;
                    const float e0 = (scol <= t0) ? s0[j] * __expf(cc - fmaxf(pmA[j], m_st)) : 0.f, e1 = (scol <= t1) ? s1[j] * __expf(cc - fmaxf(pmB[j], m_st)) : 0.f;
                    *(LAS unsigned short*)(sP + t0 * TS + scol * 2) = (unsigned short)(pk2(e0, 0.f) & 0xffffu); *(LAS unsigned short*)(sP + t1 * TS + scol * 2) = (unsigned short)(pk2(e1, 0.f) & 0xffffu); }
                f32x4 wi;
#pragma unroll
                for (int j = 0; j < 4; ++j) wi[j] = __expf(m_st - fmaxf(pmC[j], m_st));
                acc[0] *= wi; acc[1] *= wi; acc[2] *= wi;
                unsigned lo[8], hi[8];
#pragma unroll
                for (int e = 0; e < 8; ++e) { const float w = __expf((e < 4 ? u0[e & 3] : u1[e & 3]) - mrel); lo[e] = pk2(bf2f(kk[e] & 0xffffu) * w, 0.f) & 0xffffu; hi[e] = pk2(bf2f(kk[e] >> 16) * w, 0.f) & 0xffffu; }
                u32x4 a, c; a.x = lo[0] | (lo[1] << 16); a.y = lo[2] | (lo[3] << 16); a.z = lo[4] | (lo[5] << 16); a.w = lo[6] | (lo[7] << 16);
                c.x = hi[0] | (hi[1] << 16); c.y = hi[2] | (hi[3] << 16); c.z = hi[4] | (hi[5] << 16); c.w = hi[6] | (hi[7] << 16);
                *(LAS u32x4*)(sKt + (2 * lane) * TS + wid * 16) = a; *(LAS u32x4*)(sKt + (2 * lane + 1) * TS + wid * 16) = c;
            }
            __syncthreads();
            {
                bf16x8 fP[2], fKt[2], fV[5][2];
                ld_frag<2>(fP, sP, TS, w3 * 16, fr, fq); ld_frag<2>(fKt, sKt, TS, wid * 16, fr, fq);
#pragma unroll
                for (int n = 0; n < 5; ++n) ld_frag<2>(fV[n], sVt, TS, n * 16, fr, fq);
                if (mt0 == 0) { acc[0] = mma_frag<2>(fP, fV[0], acc[0]); acc[1] = mma_frag<2>(fP, fV[2], acc[1]); }
                else { acc[0] = mma_frag<2>(fP, fV[1], acc[0]); acc[1] = mma_frag<2>(fP, fV[3], acc[1]); }
                if (wid < 4) acc[2] = mma_frag<2>(fP, fV[4], acc[2]);
                const float dec = __expf(m_st - mrel);
#pragma unroll
                for (int n = 0; n < 5; ++n) { CT[n] *= dec; CT[n] = mma_frag<2>(fKt, fV[n], CT[n]); }
                if (wid < 4 && fr == 0) *(LAS f32x4*)(sDen + wid * 16 + fq * 4) = acc[2];
#pragma unroll
                for (int n = 0; n < 5; ++n) { u32x2 w; w.x = pk2(CT[n][0], CT[n][1]); w.y = pk2(CT[n][2], CT[n][3]); *(LAS u32x2*)(sC + (n * 16 + fr) * QS + (wid * 16 + fq * 4) * 2) = w; }
            }
            __syncthreads();
            { const f32x4 pm4 = *(const LAS f32x4*)(pp + 128 + w3 * 16 + fq * 4), bc4 = *(const LAS f32x4*)(pp + w3 * 16 + fq * 4), dn4 = *(const LAS f32x4*)(sDen + w3 * 16 + fq * 4);
              bf16* yp = Yo + (size_t)ML_TOK(ci, w3 * 16 + fq * 4) * D + h * 256 + slice * 64 + mt0 * 16 + fr;
              const long ystep = dir ? -(long)D : (long)D;
#pragma unroll
              for (int j = 0; j < 4; ++j) { const float rdn = __frcp_rn(fmaxf(fabsf(dn4[j]), __expf(-(bc4[j] + fmaxf(pm4[j], m_st)))));
                  yp[j * ystep] = (bf16)(pk2(acc[0][j] * rdn, 0.f) & 0xffffu); yp[j * ystep + 32] = (bf16)(pk2(acc[1][j] * rdn, 0.f) & 0xffffu); } }
        }
#undef ML_LOAD
#undef ML_TOK
    }
}

__device__ __forceinline__ void hgrn_phase(ldsp lds, const bf16* P, bf16* YF, bf16* YB, int vcu, int G_) {
    const int tid = threadIdx.x, lane = tid & 63, wid = __builtin_amdgcn_readfirstlane(tid >> 6), fr = lane & 15, fq = lane >> 4;
    ldsp sQs = lds, sQm = sQs + 64 * QS, sKm = sQm + 64 * QS, sKet = sKm + 64 * QS, sVt = sKet + 128 * TS, sP = sVt + 64 * TS, sS = sP + 64 * TS;
    LAS float* sSeg = (LAS float*)(sS + 64 * QS);
    LAS float* sDec = sSeg + 8 * 128;
    for (int unit = vcu; unit < 256; unit += G_) {
        const int slice = unit & 1, dir = (unit >> 1) & 1, h = (unit >> 2) & 15, b = unit >> 6;
        bf16* Yo = dir ? YB : YF;
        __syncthreads();
        for (int i = tid; i < 64 * QS / 4; i += 512) ((LAS unsigned*)sS)[i] = 0u;
        f32x4 ST[4];
#pragma unroll
        for (int n = 0; n < 4; ++n) ST[n] = (f32x4){0.f, 0.f, 0.f, 0.f};
        unsigned rq[8], rl[8], rv[8];
#define HG_TOK(ci, i) (b * SEQ + (dir ? (SEQ - 1 - ((ci) * 64 + (i))) : ((ci) * 64 + (i))))
#define HG_LOAD(ci) do { \
            _Pragma("unroll") for (int e = 0; e < 8; ++e) { const bf16* rp = P + (size_t)HG_TOK(ci, wid * 8 + e) * N_IN1 + h * 128; \
                rq[e] = *(const unsigned*)(rp + 2 * lane); rl[e] = *(const unsigned*)(rp + 6144 + dir * 2048 + 2 * lane); rv[e] = rp[2048 + slice * 64 + lane]; } } while (0)
        HG_LOAD(0);
        const int w3 = wid & 3, mt0 = wid >> 2, mt1 = mt0 + 2;
#pragma unroll 1
        for (int ci = 0; ci < 32; ++ci) {
            float l0[8], l1[8], c0[8], c1[8]; unsigned qc[8];
            { float a0 = 0.f, a1 = 0.f;
#pragma unroll
              for (int e = 0; e < 8; ++e) { l0[e] = bf2f(rl[e] & 0xffffu); l1[e] = bf2f(rl[e] >> 16); a0 += l0[e]; a1 += l1[e]; c0[e] = a0; c1[e] = a1; qc[e] = rq[e]; }
              *(LAS f32x2_t*)(sSeg + wid * 128 + 2 * lane) = (f32x2_t){a0, a1}; }
            { u32x4 w; w.x = rv[0] | (rv[1] << 16); w.y = rv[2] | (rv[3] << 16); w.z = rv[4] | (rv[5] << 16); w.w = rv[6] | (rv[7] << 16); *(LAS u32x4*)(sVt + lane * TS + wid * 16) = w; }
            if (ci + 1 < 32) HG_LOAD(ci + 1);
            __syncthreads();
            { float off0 = 0.f, off1 = 0.f, mid0 = 0.f, mid1 = 0.f, end0 = 0.f, end1 = 0.f;
              f32x2_t sg[8];
#pragma unroll
              for (int s = 0; s < 8; ++s) sg[s] = *(const LAS f32x2_t*)(sSeg + s * 128 + 2 * lane);
#pragma unroll
              for (int s = 0; s < 8; ++s) { if (s < wid) { off0 += sg[s].x; off1 += sg[s].y; } if (s < 4) { mid0 += sg[s].x; mid1 += sg[s].y; } end0 += sg[s].x; end1 += sg[s].y; }
              if (wid == 0) *(LAS f32x2_t*)(sDec + 2 * lane) = (f32x2_t){__expf(end0), __expf(end1)};
              unsigned lo[8], hi[8];
              const float im0 = __expf(-mid0), im1 = __expf(-mid1), em0 = __expf(end0 - mid0), em1 = __expf(end1 - mid1);
#pragma unroll
              for (int e = 0; e < 8; ++e) { const int t = wid * 8 + e; const float b0 = c0[e] + off0, b1 = c1[e] + off1;
                  const float q0 = bf2f(qc[e] & 0xffffu), q1 = bf2f(qc[e] >> 16);
                  const float k0 = 1.0f - __expf(l0[e]), k1 = 1.0f - __expf(l1[e]);
                  const float qs0 = q0 * __expf(b0), qs1 = q1 * __expf(b1), km0 = k0 * __expf(mid0 - b0), km1 = k1 * __expf(mid1 - b1);
                  *(LAS unsigned*)(sQs + t * QS + lane * 4) = pk2(qs0, qs1);
                  *(LAS unsigned*)(sQm + t * QS + lane * 4) = pk2(qs0 * im0, qs1 * im1);
                  *(LAS unsigned*)(sKm + t * QS + lane * 4) = pk2(km0, km1);
                  lo[e] = pk2(km0 * em0, 0.f) & 0xffffu; hi[e] = pk2(km1 * em1, 0.f) & 0xffffu; }
              u32x4 a, c; a.x = lo[0] | (lo[1] << 16); a.y = lo[2] | (lo[3] << 16); a.z = lo[4] | (lo[5] << 16); a.w = lo[6] | (lo[7] << 16);
              c.x = hi[0] | (hi[1] << 16); c.y = hi[2] | (hi[3] << 16); c.z = hi[4] | (hi[5] << 16); c.w = hi[6] | (hi[7] << 16);
              *(LAS u32x4*)(sKet + (2 * lane) * TS + wid * 16) = a; *(LAS u32x4*)(sKet + (2 * lane + 1) * TS + wid * 16) = c; }
            __syncthreads();
            f32x4 acc[2];
            { const f32x4 z4 = (f32x4){0.f, 0.f, 0.f, 0.f};
              f32x4 s0 = z4, s1 = z4;
              { bf16x8 fK[4], fa0[4], fa1[4];
                ld_frag<4>(fK, sKm, QS, w3 * 16, fr, fq); ld_frag<4>(fa0, sQm, QS, mt0 * 16, fr, fq); ld_frag<4>(fa1, sQm, QS, mt1 * 16, fr, fq);
                if (w3 <= mt0) s0 = mma_frag<4>(fa0, fK, s0);
                s1 = mma_frag<4>(fa1, fK, s1); }
              { bf16x8 fQ[4], fb0[4], fb1[4];
                ld_frag<4>(fQ, sQs, QS, w3 * 16, fr, fq); ld_frag<4>(fb0, sS, QS, mt0 * 16, fr, fq); ld_frag<4>(fb1, sS, QS, mt1 * 16, fr, fq);
                acc[0] = mma_frag<4>(fQ, fb0, z4); acc[1] = mma_frag<4>(fQ, fb1, z4); }
              const int scol = w3 * 16 + fr;
#pragma unroll
              for (int j = 0; j < 4; ++j) { const int t0 = mt0 * 16 + fq * 4 + j, t1 = mt1 * 16 + fq * 4 + j;
                  *(LAS unsigned short*)(sP + t0 * TS + scol * 2) = (unsigned short)(pk2((scol <= t0) ? s0[j] : 0.f, 0.f) & 0xffffu);
                  *(LAS unsigned short*)(sP + t1 * TS + scol * 2) = (unsigned short)(pk2((scol <= t1) ? s1[j] : 0.f, 0.f) & 0xffffu); } }
            __syncthreads();
            { bf16x8 fP[2], fKt[2], fV[4][2];
              ld_frag<2>(fP, sP, TS, w3 * 16, fr, fq); ld_frag<2>(fKt, sKet, TS, wid * 16, fr, fq);
#pragma unroll
              for (int n = 0; n < 4; ++n) ld_frag<2>(fV[n], sVt, TS, n * 16, fr, fq);
              const f32x4 dec = *(const LAS f32x4*)(sDec + wid * 16 + fq * 4);
              if (mt0 == 0) { acc[0] = mma_frag<2>(fP, fV[0], acc[0]); acc[1] = mma_frag<2>(fP, fV[2], acc[1]); }
              else { acc[0] = mma_frag<2>(fP, fV[1], acc[0]); acc[1] = mma_frag<2>(fP, fV[3], acc[1]); }
#pragma unroll
              for (int n = 0; n < 4; ++n) { ST[n] *= dec; ST[n] = mma_frag<2>(fKt, fV[n], ST[n]); }
#pragma unroll
              for (int n = 0; n < 4; ++n) { u32x2 w; w.x = pk2(ST[n][0], ST[n][1]); w.y = pk2(ST[n][2], ST[n][3]); *(LAS u32x2*)(sS + (n * 16 + fr) * QS + (wid * 16 + fq * 4) * 2) = w; } }
            { bf16* yp = Yo + (size_t)HG_TOK(ci, w3 * 16 + fq * 4) * D + h * 128 + slice * 64 + mt0 * 16 + fr;
              const long ystep = dir ? -(long)D : (long)D;
#pragma unroll
              for (int j = 0; j < 4; ++j) { yp[j * ystep] = (bf16)(pk2(acc[0][j], 0.f) & 0xffffu); yp[j * ystep + 32] = (bf16)(pk2(acc[1][j], 0.f) & 0xffffu); } }
            __syncthreads();
        }
#undef HG_LOAD
#undef HG_TOK
    }
}

#define XB_TMO      128
#define XB_XCNT(j)  (256  + 64 * (j))
#define XB_XSUB(j)  (1280 + 64 * (j))
#define XB_XGEN(j)  (2304 + 64 * (j))
#define XB_TOP      3328
#define XB_TOPGEN   3392
#define XCD_BAR_WORDS 3456
#define XB_SPIN_CAP (1u << 18)

__device__ __forceinline__ unsigned xb_ld(unsigned* p)              { return __hip_atomic_load(p, __ATOMIC_RELAXED, __HIP_MEMORY_SCOPE_AGENT); }
__device__ __forceinline__ unsigned xb_add(unsigned* p, unsigned v) { return __hip_atomic_fetch_add(p, v, __ATOMIC_RELAXED, __HIP_MEMORY_SCOPE_AGENT); }
__device__ __forceinline__ unsigned xb_xcc_id() { return (unsigned)__builtin_amdgcn_s_getreg((3 << 11) | 20) & 0xFu; }
#define XB_SPIN(cond, bar) do { unsigned _sp = 0; while (cond) { __builtin_amdgcn_s_sleep(1); \
    if ((++_sp & 255u) == 0u) { if (xb_ld(&(bar)[XB_TMO])) break; if (_sp > XB_SPIN_CAP) { atomicAdd(&(bar)[XB_TMO], 1u); break; } } } } while (0)

struct XcdBarrier {
    unsigned* bar; unsigned x;
    volatile LAS unsigned* st;
};

__device__ __forceinline__ XcdBarrier xcd_barrier_post(unsigned* bar, volatile LAS unsigned* st) {
    XcdBarrier b; b.bar = bar; b.x = xb_xcc_id(); b.st = st;
    if (threadIdx.x == 0) (void)xb_add(&bar[XB_XCNT(b.x)], 1u);
    return b;
}
__device__ __forceinline__ void xcd_barrier_complete(unsigned* bar, unsigned x, unsigned& nloc, unsigned& nx) {
    const unsigned G = gridDim.x * gridDim.y * gridDim.z;
    unsigned sum, cnt, mine, sp = 0u;
    for (;;) {
        sum = 0u; cnt = 0u; mine = 0u;
#pragma unroll
        for (unsigned j = 0; j < 16; ++j) { const unsigned c = xb_ld(&bar[XB_XCNT(j)]); sum += c; cnt += (c > 0u) ? 1u : 0u; mine = (j == x) ? c : mine; }
        if (sum == G) break;
        __builtin_amdgcn_s_sleep(1);
        if ((++sp & 255u) == 0u) { if (xb_ld(&bar[XB_TMO])) break; if (sp > XB_SPIN_CAP) { atomicAdd(&bar[XB_TMO], 1u); break; } }
    }
    nloc = mine > 0u ? mine : 1u; nx = cnt > 0u ? cnt : 1u;
}

__device__ __forceinline__ void xcd_barrier(const XcdBarrier& b) {
    asm volatile("s_waitcnt vmcnt(0)" ::: "memory");
    __syncthreads();
    if (threadIdx.x == 0) {
        unsigned* bar = b.bar;
        __builtin_amdgcn_s_waitcnt(0);
        unsigned nloc = b.st[0], nx = b.st[1];
        if (nloc == 0u) { xcd_barrier_complete(bar, b.x, nloc, nx); b.st[0] = nloc; b.st[1] = nx; }
        const unsigned old = xb_add(&bar[XB_XSUB(b.x)], 1u);
        const unsigned gen = old / nloc;
        if (old + 1u == (gen + 1u) * nloc) {
            __builtin_amdgcn_fence(__ATOMIC_RELEASE, "agent");
            asm volatile("s_waitcnt vmcnt(0)" ::: "memory");
            const unsigned og = xb_add(&bar[XB_TOP], 1u);
            const unsigned tg = og / nx;
            if (og + 1u == (tg + 1u) * nx) xb_add(&bar[XB_TOPGEN], 1u);
            else XB_SPIN(xb_ld(&bar[XB_TOPGEN]) == tg, bar);
            __builtin_amdgcn_fence(__ATOMIC_ACQUIRE, "agent");
            xb_add(&bar[XB_XGEN(b.x)], 1u);
            asm volatile("s_waitcnt vmcnt(0)" ::: "memory");
        } else {
            XB_SPIN(xb_ld(&bar[XB_XGEN(b.x)]) == gen, bar);
            __builtin_amdgcn_fence(__ATOMIC_ACQUIRE, "agent");
            asm volatile("s_waitcnt vmcnt(0)" ::: "memory");
        }
    }
    __syncthreads();
}

struct Args { const float* in[16]; float* out; unsigned char* ws; };
__global__ void __launch_bounds__(512, 2) fwd_megakernel(Args a) {
    extern __shared__ __attribute__((aligned(16))) unsigned char lds_raw[];
    cg::grid_group grid = cg::this_grid();
    ldsp lds = (ldsp)lds_raw;
    const int tid = threadIdx.x, lane = tid & 63, wave = __builtin_amdgcn_readfirstlane(tid >> 6);
    const int G_ = gridDim.x, bx = blockIdx.x;
    const int vcu = (G_ % 8 == 0) ? (bx % 8) * (G_ / 8) + bx / 8 : bx;
    const int gw = vcu * 8 + wave, NGW = G_ * 8;
    unsigned char* ws = a.ws;
    volatile LAS unsigned* MISC = (volatile LAS unsigned*)(lds + 131072 + 320);
    if (tid < 32) MISC[tid] = 0u;
    __syncthreads();
    XcdBarrier bar = xcd_barrier_post((unsigned*)ws, MISC + 8);
    if (ws == nullptr) grid.sync();
    const float* x = a.in[0]; const float* norm_mix_g = a.in[1]; const float* norm_ffn_g = a.in[2];
    const float* ml_w_in = a.in[3]; const float* ml_b_gate = a.in[4]; const float* ml_head_g = a.in[5]; const float* ml_w_out = a.in[6];
    const float* hg_w_in = a.in[7]; const float* hg_lb = a.in[8]; const float* hg_head_g = a.in[9]; const float* hg_w_out = a.in[10];
    const float* ffn_w_up = a.in[11]; const float* ffn_conv_w = a.in[12]; const float* ffn_conv_b = a.in[13]; const float* ffn_w_down = a.in[14]; const float* final_g = a.in[15];
    bf16* Win0 = (bf16*)(ws + WS_WIN0); bf16* Wout0 = (bf16*)(ws + WS_WOUT0); bf16* Win1 = (bf16*)(ws + WS_WIN1); bf16* Wout1 = (bf16*)(ws + WS_WOUT1);
    bf16* Wup = (bf16*)(ws + WS_WUP); bf16* Wdn = (bf16*)(ws + WS_WDN);
    float* SS = (float*)(ws + WS_SS); float* EDGE = (float*)(ws + WS_EDGE);
    bf16* HN = (bf16*)(ws + WS_HN); float* H = (float*)(ws + WS_H); float* G0 = (float*)(ws + WS_G0);
    bf16* PU = (bf16*)(ws + WS_PU); bf16* YF = (bf16*)(ws + WS_YF); bf16* YB = (bf16*)(ws + WS_YB); bf16* Y = (bf16*)(ws + WS_Y); bf16* Z = (bf16*)(ws + WS_Z);
#ifndef PHMASK
#define PHMASK 0xffff
#endif
#define PH(k) ((PHMASK >> (k)) & 1)
#define GSYNC() xcd_barrier(bar)

    if (PH(0)) {
        LAS float* scr = (LAS float*)(lds + wave * 16384);
        constexpr int I0 = 32 * (N_IN0 / 32), I1 = 32 * 64, I2 = 32 * (N_IN1 / 32), I3 = 32 * 64, I4 = 32 * (FF2 / 32), I5 = (FF / 64) * 64;
        constexpr int NITEMS = I0 + I1 + I4;
        for (int it = gw; it < NITEMS; it += NGW) {
            int r = it;
            if (r < I4) { p0_transpose_item(ffn_w_up, D, FF2, Wup, scr, r, lane, norm_ffn_g, true); continue; } r -= I4;
            if (r < I1) { p0_transpose_item(ml_w_out, D, D, Wout0, scr, r, lane); continue; } r -= I1;
            p0_transpose_item(ml_w_in, D, N_IN0, Win0, scr, r, lane, norm_mix_g);
        }
        cast_rows(x, HN, SS, gw, NGW, lane);
    }
    GSYNC();
#define RUN_LAYER(layer) do { \
        if (PH(1) && layer == 0) { \
            gate_gemm(lds, HN, Win0 + (size_t)LDP0 * D, SS, ml_b_gate, G0, bx, G_); \
            pg8::Gemm g{HN, Win0, T, LDP0, D}; pg8::StaticOrder S; S.init(T, LDP0, G_, bx); \
            pg8::EpiX<1> E{PU, LDP0, G0, ml_b_gate, SS + (size_t)2 * layer * T * 32}; \
            pg8::gemm_phase<pg8::EpiX<1>, pg8::StaticOrder, true, true>(lds, g, S, E); \
        } else if (PH(2)) { \
            pg8::Gemm g{HN, Win1, T, N_IN1, D}; pg8::StaticOrder S; S.init(T, N_IN1, G_, bx); \
            pg8::EpiX<2> E{PU, N_IN1, nullptr, hg_lb, SS + (size_t)2 * layer * T * 32}; \
            pg8::gemm_phase<pg8::EpiX<2>, pg8::StaticOrder, true, true>(lds, g, S, E); \
        } \
        GSYNC(); \
        if (layer == 0) { if (PH(3)) mlstm_phase(lds, PU, G0, YF, YB, vcu, G_); } else if (PH(4)) hgrn_phase(lds, PU, YF, YB, vcu, G_); \
        GSYNC(); \
        if (!PH(5)) {} else if (layer == 0) gatenorm<256, false>(YF, YB, PU + 4096, LDP0, ml_head_g, Y, gw, NGW, lane); \
        else gatenorm<128, true>(YF, YB, PU + 4096, N_IN1, hg_head_g, Y, gw, NGW, lane); \
        GSYNC(); \
        if (PH(6)) { \
            pg8::Gemm g{Y, layer == 0 ? Wout0 : Wout1, T, D, D}; pg8::StaticOrder S; S.init(T, D, G_, bx); \
            if (layer == 0) { pg8::EpiRes<true, true> E{x, D, HN, SS + (size_t)T * 32}; pg8::gemm_phase<pg8::EpiRes<true, true>, pg8::StaticOrder, true, true>(lds, g, S, E); } \
            else { pg8::EpiRes<false, true> E{nullptr, D, HN, SS + (size_t)3 * T * 32}; pg8::gemm_phase<pg8::EpiRes<false, true>, pg8::StaticOrder, true, true>(lds, g, S, E); } \
        } \
        GSYNC(); \
        if (PH(7)) { \
            pg8::Gemm g{HN, Wup + (size_t)layer * FF2 * D, T, FF2, D}; \
            pg8::EpiGLU E{Z, EDGE, ffn_conv_w + (size_t)layer * 3 * FF, ffn_conv_b + (size_t)layer * FF, SS + (size_t)(2 * layer + 1) * T * 32, (LAS float*)(lds + 131072 + 2048)}; \
            const int tail0 = (G_ > UP_TAIL) ? UP_TAIL : 0; \
            constexpr int J3 = 32 * 64, J5 = (FF / 64) * 64, NT_MAIN = 32 * 40, NT_ALL = 32 * (FF2 / 256); \
            constexpr int FE = 40 * 128;                         \
            const float* wu1 = ffn_w_up + (size_t)D * FF2; bf16* wu1t = Wup + (size_t)FF2 * D; \
            if (layer == 0) { \
                pg8::StaticOrder S; S.init(T, FF2, G_, bx); \
                pg8::gemm_phase<pg8::EpiGLU, pg8::StaticOrder, true, true>(lds, g, S, E); \
                if (bx >= tail0) {     \
                    { int tid3 = threadIdx.x; asm volatile("" : "+v"(tid3)); const int lane3 = tid3 & 63, wave3 = __builtin_amdgcn_readfirstlane(tid3 >> 6); \
                    const int tw = (bx - tail0) * 8 + wave3, tn = (G_ - tail0) * 8; LAS float* scr = (LAS float*)(lds + wave3 * 16384); \
                    p0_convert(P0Mat{wu1, wu1t, norm_ffn_g + D, D, FF - FE, true, FF2, FE}, 32 * ((FF - FE) / 32), tw, tn, lane3, scr); \
                    p0_convert(P0Mat{wu1, wu1t, norm_ffn_g + D, D, FF - FE, true, FF2, FF + FE}, 32 * ((FF - FE) / 32), tw, tn, lane3, scr); \
                    p0_convert(P0Mat{hg_w_out, Wout1, nullptr, D, D, false}, J3, tw, tn, lane3, scr); \
                    p0_convert(P0Mat{hg_w_in, Win1, norm_mix_g + D, D, N_IN1, false}, 32 * (N_IN1 / 32), tw, tn, lane3, scr); \
                    p0_convert(P0Mat{ffn_w_down, Wdn, nullptr, FF, D, false}, J5, tw, tn, lane3, scr); } \
                } \
            } else {     \
                { pg8::SubOrder S; S.init(T, FF2, G_, bx); S.lo = NT_MAIN; S.hi = NT_ALL; \
                  pg8::gemm_phase<pg8::EpiGLU, pg8::SubOrder, true, true>(lds, g, S, E); } \
                if (bx >= tail0) { \
                    { int tid3 = threadIdx.x; asm volatile("" : "+v"(tid3)); const int lane3 = tid3 & 63, wave3 = __builtin_amdgcn_readfirstlane(tid3 >> 6); \
                    const int tw = (bx - tail0) * 8 + wave3, tn = (G_ - tail0) * 8; LAS float* scr = (LAS float*)(lds + wave3 * 16384); \
                    p0_convert(P0Mat{wu1, wu1t, norm_ffn_g + D, D, FE, true, FF2, 0}, 32 * (FE / 32), tw, tn, lane3, scr); \
                    p0_convert(P0Mat{wu1, wu1t, norm_ffn_g + D, D, FE, true, FF2, FF}, 32 * (FE / 32), tw, tn, lane3, scr); \
                    p0_convert(P0Mat{ffn_w_down + (size_t)FF * D, Wdn + (size_t)D * FF, nullptr, FF, D, false}, J5, tw, tn, lane3, scr); } \
                } \
                GSYNC(); \
                { pg8::SubOrder S; S.init(T, FF2, G_, bx); S.lo = 0; S.hi = NT_MAIN; \
                  pg8::gemm_phase<pg8::EpiGLU, pg8::SubOrder, true, true>(lds, g, S, E); } \
            } \
        } \
        GSYNC(); \
        if (PH(9)) { \
            pg8::Gemm g{Z, Wdn + (size_t)layer * D * FF, T, D, FF}; pg8::StaticOrder S; S.init(T, D, G_, bx); \
            { pg8::Unit u0; S.next(0, u0); glu_fixup(EDGE, ffn_conv_w + (size_t)layer * 3 * FF, ffn_conv_b + (size_t)layer * FF, Z, u0.pm); } \
            if (layer == 0) { pg8::EpiRes<false, true> E{nullptr, D, HN, SS + (size_t)2 * T * 32}; pg8::gemm_phase<pg8::EpiRes<false, true>, pg8::StaticOrder, true, true>(lds, g, S, E); } \
            else { pg8::EpiRes<false, false> E{nullptr, D, HN, nullptr}; pg8::gemm_phase<pg8::EpiRes<false, false>, pg8::StaticOrder, true, true>(lds, g, S, E); } \
        } \
        GSYNC(); \
     \
    } while (0)
    RUN_LAYER(0);
    RUN_LAYER(1);
    { int tid2 = threadIdx.x; asm volatile("" : "+v"(tid2));
      const int lane2 = tid2 & 63, gw2 = vcu * 8 + (tid2 >> 6);
      rms_rows_final(HN, final_g, a.out, gw2, NGW, lane2); }
}

extern "C" void kernel_launch(void* const* d_in, const int* in_sizes, int n_in, void* d_out, int out_size, void* d_ws, size_t ws_size, hipStream_t stream) {
    static int grid = 0;
    if (grid == 0) {
        if (n_in != 16 || out_size != T * D || ws_size < WS_END2) { fprintf(stderr, "kernel_launch: unexpected problem (n_in %d, out %d, ws %zu)\n", n_in, out_size, ws_size); grid = -1; return; }
        int dev = 0, cus = 0, per_cu = 0;
        hipGetDevice(&dev); hipDeviceGetAttribute(&cus, hipDeviceAttributeMultiprocessorCount, dev);
        if (hipFuncSetAttribute((const void*)fwd_megakernel, hipFuncAttributeMaxDynamicSharedMemorySize, LDS_BYTES) != hipSuccess) { fprintf(stderr, "kernel_launch: hipFuncSetAttribute failed\n"); grid = -1; return; }
        if (hipOccupancyMaxActiveBlocksPerMultiprocessor(&per_cu, (const void*)fwd_megakernel, 512, LDS_BYTES) != hipSuccess || per_cu < 1) { fprintf(stderr, "kernel_launch: occupancy query failed (%d)\n", per_cu); (void)hipGetLastError(); per_cu = 1; }
        grid = cus * per_cu;
    }
    if (grid < 0) return;
    if (hipMemsetAsync(d_ws, 0, 16384, stream) != hipSuccess) { fprintf(stderr, "kernel_launch: memset failed\n"); return; }
    Args a{};
    for (int i = 0; i < 16; ++i) a.in[i] = (const float*)d_in[i];
    a.out = (float*)d_out; a.ws = (unsigned char*)d_ws;
    void* args[] = {&a};
    hipError_t e = hipLaunchCooperativeKernel((const void*)fwd_megakernel, dim3(grid), dim3(512), args, LDS_BYTES, stream);
    if (e != hipSuccess) fprintf(stderr, "kernel_launch: cooperative launch failed: %s (grid %d)\n", hipGetErrorString(e), grid);
}
```

```cpp
#include <hip/hip_runtime.h>
#include <hip/hip_cooperative_groups.h>
#include <cstdio>
#include <cstdint>
namespace cg = cooperative_groups;
namespace pg8 {
#define PG8_LAS __attribute__((address_space(3)))
typedef unsigned short bf16_t;
typedef short bf16x8 __attribute__((ext_vector_type(8)));
typedef float f32x4 __attribute__((ext_vector_type(4)));
typedef unsigned u32x4 __attribute__((ext_vector_type(4)));
constexpr int BM = 256, BK = 64, HALF = 128, HTB = HALF * BK * 2  , STAGE_BYTES = 8 * HTB, NXCD = 8, WGM = 4;

__host__ __device__ __forceinline__ int lds_byte(int r, int c) { const int st = (r >> 4) * 2 + (c >> 5), rr = r & 15, cc = c & 31, ob = rr * 64 + cc * 2; return st * 1024 + (ob ^ (((ob >> 9) & 1) << 5)); }
__host__ __device__ __forceinline__ void stage_rc(int b, int& R, int& C) { const int st = b / 1024, sb = b % 1024, swz = sb ^ (((sb >> 9) & 1) << 5); R = (st >> 1) * 16 + swz / 64; C = (st & 1) * 32 + (swz % 64) / 2; }
__host__ __device__ __forceinline__ int perm32(int rho) { const int n = rho >> 4, i = rho & 15; return 8 * (i >> 2) + 4 * n + (i & 3); }

struct Unit { int pm, pn; };
struct Gemm { const bf16_t* A; const bf16_t* Bt; int M, N, K; };

struct StaticOrder {
    int nM, nN, nwg, G, c;
    __host__ __device__ void init(int M, int N, int G_, int c_) { nM = M / BM; nN = N / BM; nwg = nM * nN; G = G_; c = c_; }
    __host__ __device__ bool next(int i, Unit& u) const {
        const long L = (long)i * G + c; if (L >= nwg) return false;
        int wgid = (int)L; { const int q = nwg / NXCD, r = nwg % NXCD, xcd = wgid % NXCD, off = wgid / NXCD; wgid = (xcd < r ? xcd * (q + 1) : r * (q + 1) + (xcd - r) * q) + off; }
        const int nig = WGM * nN, gid = wgid / nig, fm = gid * WGM, gsz = (nM - fm) < WGM ? (nM - fm) : WGM;
        u.pm = fm + ((wgid % nig) % gsz); u.pn = (wgid % nig) / gsz; return true;
    }
    __device__ __forceinline__ void a_ready(const Unit&) const {}
    __device__ __forceinline__ void done(const Unit&) const {}
};

typedef __bf16 bf16x2v __attribute__((ext_vector_type(2)));
typedef float f32x2v_ __attribute__((ext_vector_type(2)));
__device__ __forceinline__ unsigned cvt_pk_bf16(float lo, float hi) { f32x2v_ f = {lo, hi}; bf16x2v v = __builtin_convertvector(f, bf16x2v); return __builtin_bit_cast(unsigned, v); }
typedef float f32x2 __attribute__((ext_vector_type(2)));
__device__ __forceinline__ f32x2 gelu_pk(f32x2 v) {
    const f32x2 av = __builtin_elementwise_abs(v), d = av * 0.2316418882f + 1.0f;
    f32x2 t; t.x = __builtin_amdgcn_rcpf(d.x); t.y = __builtin_amdgcn_rcpf(d.y);
    f32x2 q = t * 0.5307027145f + (-0.7265760135f); q = q * t + 0.7107068705f; q = q * t + (-0.142248368f); q = q * t + 0.127414796f; q = q * t;
    const f32x2 s = (v * v) * (-0.72134752044f);
    f32x2 e; e.x = __builtin_amdgcn_exp2f(s.x); e.y = __builtin_amdgcn_exp2f(s.y);
    const f32x2 m = v * (q * e), r = v - m;
    f32x2 o; o.x = v.x < 0.f ? m.x : r.x; o.y = v.y < 0.f ? m.y : r.y; return o;
}


struct SubOrder : StaticOrder {
    int lo, hi;
    __host__ __device__ bool next(int i, Unit& u) const {
        const long L = (long)lo + (long)i * G + c; if (L >= hi) return false;
        int wgid = (int)L; { const int q = nwg / NXCD, r = nwg % NXCD, xcd = wgid % NXCD, off = wgid / NXCD; wgid = (xcd < r ? xcd * (q + 1) : r * (q + 1) + (xcd - r) * q) + off; }
        const int nig = WGM * nN, gid = wgid / nig, fm = gid * WGM, gsz = (nM - fm) < WGM ? (nM - fm) : WGM;
        u.pm = fm + ((wgid % nig) % gsz); u.pn = (wgid % nig) / gsz; return true;
    }
};

template <int MODE> struct EpiX {
    static constexpr bool PERM = true, AFTER_DRAIN = false;
    bf16_t* O; int ldc; float* G; const float* aux; const float* ss;
    __device__ __forceinline__ void operator()(const f32x4 (&acc)[2][2][4][2], const Unit& u, int wr, int wc, int fr, int fq) const {
        const int row0 = u.pm * BM + wr * 64 + fr; const int colt = u.pn * BM;
        const float sc = (MODE == 1 && colt < 1024) ? 0.08838834764831845f : 1.0f;
        const int col0 = colt + wc * 32 + 8 * fq;
        const bool lfmode = (MODE == 2) && (colt >= 6144);
        float lb[2][8];
        if (MODE == 2) {
#pragma unroll
            for (int bj = 0; bj < 2; ++bj) {
                if (lfmode) { const int ci = (col0 + bj * HALF - 6144) & 2047;
                    const f32x4 l00 = *(const f32x4*)(aux + ci), l01 = *(const f32x4*)(aux + ci + 4), l10 = *(const f32x4*)(aux + 2048 + ci), l11 = *(const f32x4*)(aux + 2048 + ci + 4);
#pragma unroll
                    for (int e = 0; e < 4; ++e) { lb[bj][e] = __builtin_amdgcn_rcpf(1.0f + __expf(l00[e] - l10[e])); lb[bj][4 + e] = __builtin_amdgcn_rcpf(1.0f + __expf(l01[e] - l11[e])); } }
                else {
#pragma unroll
                    for (int e = 0; e < 8; ++e) lb[bj][e] = 0.f; } }
        }
#pragma unroll
        for (int ai = 0; ai < 2; ++ai) {
            f32x4 t4[4];
#pragma unroll
            for (int m = 0; m < 4; ++m) { const f32x4* sp = (const f32x4*)(ss + (size_t)(row0 + ai * HALF + m * 16) * 32) + 2 * fq;
                t4[m] = sp[0] + sp[1]; }
            float rs[4];
#pragma unroll
            for (int m = 0; m < 4; ++m) { float tq = (t4[m][0] + t4[m][1]) + (t4[m][2] + t4[m][3]); tq += __shfl_xor(tq, 16); tq += __shfl_xor(tq, 32);
                rs[m] = rsqrtf(tq * (1.0f / 2048.0f) + 1e-6f) * sc; }
#pragma unroll
            for (int bj = 0; bj < 2; ++bj)
#pragma unroll
                for (int m = 0; m < 4; ++m) { bf16_t* rowp = O + (size_t)(row0 + ai * HALF + m * 16) * ldc + col0 + bj * HALF;
                    f32x4 v0 = acc[ai][bj][m][0] * rs[m], v1 = acc[ai][bj][m][1] * rs[m];
                    if (MODE == 2) { if (lfmode) {
#pragma unroll
                        for (int e = 0; e < 4; ++e) { const float s0 = __builtin_amdgcn_rcpf(1.0f + __expf(-v0[e])), s1 = __builtin_amdgcn_rcpf(1.0f + __expf(-v1[e]));
                            v0[e] = __logf(lb[bj][e] + (1.0f - lb[bj][e]) * s0); v1[e] = __logf(lb[bj][4 + e] + (1.0f - lb[bj][4 + e]) * s1); } } }
                    u32x4 w; w.x = cvt_pk_bf16(v0[0], v0[1]); w.y = cvt_pk_bf16(v0[2], v0[3]); w.z = cvt_pk_bf16(v1[0], v1[1]); w.w = cvt_pk_bf16(v1[2], v1[3]);
                    *(u32x4*)rowp = w; }
        }
    }
};
template <bool RESF32, bool WITH_SS> struct EpiRes {
    static constexpr bool PERM = true, AFTER_DRAIN = false;
    const float* resf; int ldc; bf16_t* hn; float* ss;
    __device__ __forceinline__ void operator()(const f32x4 (&acc)[2][2][4][2], const Unit& u, int wr, int wc, int fr, int fq) const {
        const int row0 = u.pm * BM + wr * 64 + fr, col0 = u.pn * BM + wc * 32 + 8 * fq;
#pragma unroll
        for (int ai = 0; ai < 2; ++ai) {
            f32x4 r0[4][2], r1[4][2];
            if (RESF32) {
#pragma unroll
                for (int m = 0; m < 4; ++m)
#pragma unroll
                    for (int bj = 0; bj < 2; ++bj) { const size_t off = (size_t)(row0 + ai * HALF + m * 16) * ldc + col0 + bj * HALF; r0[m][bj] = *(const f32x4*)(resf + off); r1[m][bj] = *(const f32x4*)(resf + off + 4); }
            } else {
                u32x4 rw[4][2];
#pragma unroll
                for (int m = 0; m < 4; ++m)
#pragma unroll
                    for (int bj = 0; bj < 2; ++bj) rw[m][bj] = *(const u32x4*)(hn + (size_t)(row0 + ai * HALF + m * 16) * ldc + col0 + bj * HALF);
#pragma unroll
                for (int m = 0; m < 4; ++m)
#pragma unroll
                    for (int bj = 0; bj < 2; ++bj) { const u32x4 w = rw[m][bj];
                        r0[m][bj] = (f32x4){__builtin_bit_cast(float, w.x << 16), __builtin_bit_cast(float, w.x & 0xffff0000u), __builtin_bit_cast(float, w.y << 16), __builtin_bit_cast(float, w.y & 0xffff0000u)};
                        r1[m][bj] = (f32x4){__builtin_bit_cast(float, w.z << 16), __builtin_bit_cast(float, w.z & 0xffff0000u), __builtin_bit_cast(float, w.w << 16), __builtin_bit_cast(float, w.w & 0xffff0000u)}; }
            }
#pragma unroll
            for (int m = 0; m < 4; ++m) { const int row = row0 + ai * HALF + m * 16; const size_t off = (size_t)row * ldc + col0; float q = 0.f;
#pragma unroll
                for (int bj = 0; bj < 2; ++bj) {
                    const f32x4 o0 = r0[m][bj] + acc[ai][bj][m][0], o1 = r1[m][bj] + acc[ai][bj][m][1];
                    u32x4 w; w.x = cvt_pk_bf16(o0[0], o0[1]); w.y = cvt_pk_bf16(o0[2], o0[3]); w.z = cvt_pk_bf16(o1[0], o1[1]); w.w = cvt_pk_bf16(o1[2], o1[3]);
                    *(u32x4*)(hn + off + bj * HALF) = w;
                    if (WITH_SS) q += (o0[0] * o0[0] + o0[1] * o0[1]) + (o0[2] * o0[2] + o0[3] * o0[3]) + (o1[0] * o1[0] + o1[1] * o1[1]) + (o1[2] * o1[2] + o1[3] * o1[3]); }
                if (WITH_SS) { q += __shfl_xor(q, 16); q += __shfl_xor(q, 32); if (fq == 0) ss[(size_t)row * 32 + u.pn * 4 + wc] = q; } }
        }
    }
};


__device__ __forceinline__ float dpp_ror1(float x) { return __builtin_bit_cast(float, __builtin_amdgcn_update_dpp(0, __builtin_bit_cast(int, x), 0x121, 0xf, 0xf, false)); }
__device__ __forceinline__ float dpp_ror15(float x) { return __builtin_bit_cast(float, __builtin_amdgcn_update_dpp(0, __builtin_bit_cast(int, x), 0x12f, 0xf, 0xf, false)); }
struct EpiGLU {
    static constexpr bool PERM = true, AFTER_DRAIN = false;
    bf16_t* Z; float* EDGE; const float* cw; const float* cb; const float* ss; PG8_LAS float* ebuf;
    __device__ __forceinline__ void operator()(const f32x4 (&acc)[2][2][4][2], const Unit& u, int wr, int wc, int fr, int fq) const {
        constexpr int FFc = 5504;
        const int row0 = u.pm * BM + wr * 64 + fr;
        const int lcol = wc * 32 + 8 * fq;
        const int fcol = u.pn * 128 + lcol;
        float rs[2][4];
#pragma unroll
        for (int ai = 0; ai < 2; ++ai) {
            f32x4 t4[4];
#pragma unroll
            for (int m = 0; m < 4; ++m) { const f32x4* sp = (const f32x4*)(ss + (size_t)(row0 + ai * HALF + m * 16) * 32) + 2 * fq; t4[m] = sp[0] + sp[1]; }
#pragma unroll
            for (int m = 0; m < 4; ++m) { float tq = (t4[m][0] + t4[m][1]) + (t4[m][2] + t4[m][3]); tq += __shfl_xor(tq, 16); tq += __shfl_xor(tq, 32); rs[ai][m] = rsqrtf(tq * (1.0f / 2048.0f) + 1e-6f); }
        }
        {
            const f32x4 f00 = acc[0][0][0][0] * rs[0][0], f01 = acc[0][0][0][1] * rs[0][0], l00 = acc[0][0][3][0] * rs[0][3], l01 = acc[0][0][3][1] * rs[0][3];
            const f32x4 f10 = acc[1][0][0][0] * rs[1][0], f11 = acc[1][0][0][1] * rs[1][0], l10 = acc[1][0][3][0] * rs[1][3], l11 = acc[1][0][3][1] * rs[1][3];
            PG8_LAS float* e0 = ebuf + (wr * 2) * 128 + lcol;
            if (fr == 0) { *(PG8_LAS f32x4*)(e0) = f00; *(PG8_LAS f32x4*)(e0 + 4) = f01; *(PG8_LAS f32x4*)(e0 + 512) = f10; *(PG8_LAS f32x4*)(e0 + 516) = f11; }
            if (fr == 15) { *(PG8_LAS f32x4*)(e0 + 128) = l00; *(PG8_LAS f32x4*)(e0 + 132) = l01; *(PG8_LAS f32x4*)(e0 + 640) = l10; *(PG8_LAS f32x4*)(e0 + 644) = l11; }
            if (wr == 0 && fr < 2) { float* e = EDGE + ((size_t)u.pm * 6 + fr) * FFc + fcol;
                *(f32x4*)(e) = f00; *(f32x4*)(e + 4) = f01;
                if (fr == 0) { float* ev = EDGE + ((size_t)u.pm * 6 + 4) * FFc + fcol; *(f32x4*)(ev) = acc[0][1][0][0] * rs[0][0]; *(f32x4*)(ev + 4) = acc[0][1][0][1] * rs[0][0]; } }
            if (wr == 1 && fr >= 14) { float* e = EDGE + ((size_t)u.pm * 6 + 2 + (fr - 14)) * FFc + fcol;
                *(f32x4*)(e) = l10; *(f32x4*)(e + 4) = l11;
                if (fr == 15) { float* ev = EDGE + ((size_t)u.pm * 6 + 5) * FFc + fcol; *(f32x4*)(ev) = acc[1][1][3][0] * rs[1][3]; *(f32x4*)(ev + 4) = acc[1][1][3][1] * rs[1][3]; } }
        }
        asm volatile("s_waitcnt lgkmcnt(0)" ::: "memory"); __builtin_amdgcn_s_barrier(); asm volatile("" ::: "memory");
#pragma unroll
        for (int n = 0; n < 2; ++n) {
            const f32x4 w0 = *(const f32x4*)(cw + fcol + 4 * n), w1 = *(const f32x4*)(cw + FFc + fcol + 4 * n), w2 = *(const f32x4*)(cw + 2 * FFc + fcol + 4 * n), bb = *(const f32x4*)(cb + fcol + 4 * n);
#pragma unroll
            for (int ai = 0; ai < 2; ++ai) { const int blk = ai * 2 + wr;
#pragma unroll
                for (int m = 0; m < 4; ++m) {
                    const f32x4 zero4 = (f32x4){0.f, 0.f, 0.f, 0.f};
                    const f32x4 Ac = acc[ai][0][m][n] * rs[ai][m];
                    f32x4 pvs, nxs;
                    if (m > 0) { const f32x4 Ap = acc[ai][0][m > 0 ? m - 1 : 0][n] * rs[ai][m > 0 ? m - 1 : 0];
#pragma unroll
                        for (int e = 0; e < 4; ++e) pvs[e] = dpp_ror1(Ap[e]); }
                    else pvs = (blk > 0) ? *(const PG8_LAS f32x4*)(ebuf + ((blk - 1) * 2 + 1) * 128 + lcol + 4 * n) : zero4;
                    if (m < 3) { const f32x4 An = acc[ai][0][m < 3 ? m + 1 : 3][n] * rs[ai][m < 3 ? m + 1 : 3];
#pragma unroll
                        for (int e = 0; e < 4; ++e) nxs[e] = dpp_ror15(An[e]); }
                    else nxs = (blk < 3) ? *(const PG8_LAS f32x4*)(ebuf + ((blk + 1) * 2 + 0) * 128 + lcol + 4 * n) : zero4;
                    f32x4 pv, nx;
#pragma unroll
                    for (int e = 0; e < 4; ++e) { const float r1 = dpp_ror1(Ac[e]), l1 = dpp_ror15(Ac[e]); pv[e] = (fr == 0) ? pvs[e] : r1; nx[e] = (fr == 15) ? nxs[e] : l1; }
                    const f32x4 c = bb + w0 * pv + w1 * Ac + w2 * nx;
                    const f32x4 vv = acc[ai][1][m][n] * rs[ai][m];
                    const f32x2 g0 = gelu_pk((f32x2){c[0], c[1]}), g1 = gelu_pk((f32x2){c[2], c[3]});
                    typedef unsigned u32x2e __attribute__((ext_vector_type(2)));
                    u32x2e w; w.x = cvt_pk_bf16(g0.x * vv[0], g0.y * vv[1]); w.y = cvt_pk_bf16(g1.x * vv[2], g1.y * vv[3]);
                    *(u32x2e*)(Z + (size_t)(row0 + ai * HALF + m * 16) * FFc + fcol + 4 * n) = w;
                    __builtin_amdgcn_sched_barrier(0);
                }
            }
        }
    }
};

template <class Epi, class Sched, bool ALIGN_EPI = false, bool SP2 = false>
__device__ __forceinline__ void gemm_phase(PG8_LAS unsigned char* lds, const Gemm g, const Sched& S, const Epi& E) {
    int tid_ = threadIdx.x; asm volatile("" : "+v"(tid_));
    const int tid = tid_, wid = __builtin_amdgcn_readfirstlane(tid >> 6), lane = tid & 63, wr = wid >> 2, wc = wid & 3, fr = lane & 15, fq = lane >> 4;
    const int K = g.K, nt = K / BK;
    unsigned voffA[2], voffB[2];
#pragma unroll
    for (int i = 0; i < 2; ++i) { int R, C; stage_rc(tid * 16 + i * 8192, R, C); const int Rb = Epi::PERM ? ((R & ~31) + perm32(R & 31)) : R;
        voffA[i] = (unsigned)(R * K + C) * 2u; voffB[i] = (unsigned)(Rb * K + C) * 2u; }
    const size_t kstep = (size_t)(BK * 2);
    const size_t hstep = (size_t)HALF * K * 2;
    const size_t tstep = 2 * hstep;
    const unsigned ldsw = (unsigned)wid * 1024u;
    const int aoff = lds_byte(wr * 64 + fr, fq * 8), boff = lds_byte(wc * 32 + fr, fq * 8);
#define PG8_SA(b, h) (((b) * 2 + (h)) * HTB)
#define PG8_SB(b, h) ((4 + (b) * 2 + (h)) * HTB)
#define PG8_STAGE(bufoff, gbase, voff) do { _Pragma("unroll") for (int _i = 0; _i < 2; ++_i) \
        __builtin_amdgcn_global_load_lds((const unsigned*)((const char*)(gbase) + (voff)[_i]), (PG8_LAS unsigned*)(lds + (bufoff) + ldsw + _i * 8192), 16, 0, 0); } while (0)
#define PG8_LDA(dst, b, h) do { _Pragma("unroll") for (int m = 0; m < 4; ++m) _Pragma("unroll") for (int k = 0; k < 2; ++k) dst[m][k] = *(const PG8_LAS bf16x8*)(lds + PG8_SA(b, h) + aoff + m * 2048 + k * 1024); } while (0)
#define PG8_LDB(dst, b, h) do { _Pragma("unroll") for (int n = 0; n < 2; ++n) _Pragma("unroll") for (int k = 0; k < 2; ++k) dst[n][k] = *(const PG8_LAS bf16x8*)(lds + PG8_SB(b, h) + boff + n * 2048 + k * 1024); } while (0)
#define PG8_MMA(ai, bj, At, Bt) do { __builtin_amdgcn_s_setprio(1); _Pragma("unroll") for (int m = 0; m < 4; ++m) _Pragma("unroll") for (int n = 0; n < 2; ++n) _Pragma("unroll") for (int k = 0; k < 2; ++k) \
        acc[ai][bj][m][n] = __builtin_amdgcn_mfma_f32_16x16x32_bf16(Bt[n][k], At[m][k], acc[ai][bj][m][n], 0, 0, 0); __builtin_amdgcn_s_setprio(0); } while (0)
#define PG8_WAIT_V(n) asm volatile("s_waitcnt vmcnt(" #n ")" ::: "memory")
#define PG8_WAIT_L(n) asm volatile("s_waitcnt lgkmcnt(" #n ")" ::: "memory")
#define PG8_BAR __builtin_amdgcn_s_barrier()
#define PG8_SCHED __builtin_amdgcn_sched_barrier(0)
    Unit cur, nxt; int ui = 0;
    if (!S.next(0, cur)) return;
    f32x4 acc[2][2][4][2];
#pragma unroll
    for (int a = 0; a < 2; ++a)
#pragma unroll
        for (int b = 0; b < 2; ++b)
#pragma unroll
            for (int m = 0; m < 4; ++m)
#pragma unroll
                for (int n = 0; n < 2; ++n) acc[a][b][m][n] = (f32x4){0.f, 0.f, 0.f, 0.f};
    bf16x8 At[4][2], B0[2][2], B1[2][2];
    const char* cA = (const char*)g.A + (size_t)cur.pm * tstep; const char* cB = (const char*)g.Bt + (size_t)cur.pn * tstep;
    S.a_ready(cur);
    if constexpr (SP2) {
        PG8_STAGE(PG8_SB(0, 0), cB, voffB); PG8_STAGE(PG8_SB(0, 1), cB + hstep, voffB); PG8_STAGE(PG8_SA(0, 0), cA, voffA); PG8_STAGE(PG8_SA(0, 1), cA + hstep, voffA);
        if (wr == 1) PG8_BAR;
        PG8_WAIT_V(2); PG8_BAR;
        PG8_STAGE(PG8_SB(1, 0), cB + kstep, voffB); PG8_STAGE(PG8_SA(1, 0), cA + kstep, voffA); PG8_STAGE(PG8_SB(1, 1), cB + hstep + kstep, voffB);
        PG8_WAIT_V(6); PG8_BAR;
    } else {
        PG8_STAGE(PG8_SB(0, 0), cB, voffB); PG8_STAGE(PG8_SA(0, 0), cA, voffA); PG8_STAGE(PG8_SB(0, 1), cB + hstep, voffB); PG8_STAGE(PG8_SA(0, 1), cA + hstep, voffA);
        if (wr == 1) PG8_BAR;
        PG8_WAIT_V(4); PG8_BAR;
        PG8_STAGE(PG8_SB(1, 0), cB + kstep, voffB); PG8_STAGE(PG8_SA(1, 0), cA + kstep, voffA); PG8_STAGE(PG8_SB(1, 1), cB + hstep + kstep, voffB);
        PG8_WAIT_V(6); PG8_BAR;
    }
    for (;;) {
        const bool has_next = S.next(ui + 1, nxt);
        const char* nA = has_next ? (const char*)g.A + (size_t)nxt.pm * tstep : cA; const char* nB = has_next ? (const char*)g.Bt + (size_t)nxt.pn * tstep : cB;
        for (int t = 0; t < nt; t += 2) {
            const bool last = (t == nt - 2);
            const char* a1 = cA + (size_t)(t + 1) * kstep;
            const char* a2 = last ? nA : cA + (size_t)(t + 2) * kstep; const char* b2 = last ? nB : cB + (size_t)(t + 2) * kstep;
            const char* a3 = a2 + kstep; const char* b3 = b2 + kstep;
            if (last && has_next) S.a_ready(nxt);
            if constexpr (SP2) {
            PG8_LDB(B0, 0, 0); PG8_LDB(B1, 0, 1); PG8_SCHED; PG8_LDA(At, 0, 0); PG8_STAGE(PG8_SA(1, 1), a1 + hstep, voffA);
            PG8_WAIT_V(8); PG8_WAIT_L(0); PG8_BAR; PG8_MMA(0, 0, At, B0); PG8_MMA(0, 1, At, B1); PG8_BAR; PG8_SCHED;
            PG8_LDA(At, 0, 1); PG8_STAGE(PG8_SB(0, 0), b2, voffB); PG8_STAGE(PG8_SB(0, 1), b2 + hstep, voffB); PG8_STAGE(PG8_SA(0, 0), a2, voffA);
            PG8_WAIT_V(8); PG8_WAIT_L(0); PG8_BAR; PG8_MMA(1, 0, At, B0); PG8_MMA(1, 1, At, B1); PG8_BAR; PG8_SCHED;
            PG8_LDB(B0, 1, 0); PG8_LDB(B1, 1, 1); PG8_SCHED; PG8_LDA(At, 1, 0); PG8_STAGE(PG8_SA(0, 1), a2 + hstep, voffA);
            PG8_WAIT_V(8); PG8_WAIT_L(0); PG8_BAR; PG8_MMA(0, 0, At, B0); PG8_MMA(0, 1, At, B1); PG8_BAR; PG8_SCHED;
            PG8_LDA(At, 1, 1); PG8_STAGE(PG8_SB(1, 0), b3, voffB); PG8_STAGE(PG8_SB(1, 1), b3 + hstep, voffB); PG8_STAGE(PG8_SA(1, 0), a3, voffA);
            PG8_WAIT_V(8); PG8_WAIT_L(0); PG8_BAR; PG8_MMA(1, 0, At, B0); PG8_MMA(1, 1, At, B1); PG8_BAR; PG8_SCHED;
            } else {
            PG8_LDB(B0, 0, 0); PG8_SCHED; PG8_LDA(At, 0, 0); PG8_STAGE(PG8_SA(1, 1), a1 + hstep, voffA);
            PG8_WAIT_L(8); PG8_BAR; PG8_WAIT_L(0); PG8_MMA(0, 0, At, B0); PG8_BAR; PG8_SCHED;
            PG8_LDB(B1, 0, 1); PG8_STAGE(PG8_SB(0, 0), b2, voffB);
            PG8_BAR; PG8_WAIT_L(0); PG8_MMA(0, 1, At, B1); PG8_BAR;
            PG8_LDA(At, 0, 1); PG8_STAGE(PG8_SA(0, 0), a2, voffA);
            PG8_BAR; PG8_WAIT_L(0); PG8_MMA(1, 0, At, B0); PG8_BAR; PG8_SCHED;
            PG8_STAGE(PG8_SB(0, 1), b2 + hstep, voffB);
            PG8_WAIT_V(6); PG8_BAR; PG8_MMA(1, 1, At, B1); PG8_BAR;
            PG8_LDB(B0, 1, 0); PG8_SCHED; PG8_LDA(At, 1, 0); PG8_STAGE(PG8_SA(0, 1), a2 + hstep, voffA);
            PG8_WAIT_L(8); PG8_BAR; PG8_WAIT_L(0); PG8_MMA(0, 0, At, B0); PG8_BAR; PG8_SCHED;
            PG8_LDB(B1, 1, 1); PG8_STAGE(PG8_SB(1, 0), b3, voffB);
            PG8_BAR; PG8_WAIT_L(0); PG8_MMA(0, 1, At, B1); PG8_BAR;
            PG8_LDA(At, 1, 1); PG8_STAGE(PG8_SA(1, 0), a3, voffA);
            PG8_BAR; PG8_WAIT_L(0); PG8_MMA(1, 0, At, B0); PG8_BAR; PG8_SCHED;
            PG8_STAGE(PG8_SB(1, 1), b3 + hstep, voffB);
            PG8_WAIT_V(6); PG8_BAR; PG8_MMA(1, 1, At, B1); PG8_BAR;
            }
        }
        if constexpr (ALIGN_EPI) { if (wr == 0) PG8_BAR; }
        if constexpr (!Epi::AFTER_DRAIN) { E(acc, cur, wr, wc, fr, fq); S.done(cur); }
        if (!has_next) break;
#pragma unroll
        for (int a = 0; a < 2; ++a)
#pragma unroll
            for (int b = 0; b < 2; ++b)
#pragma unroll
                for (int m = 0; m < 4; ++m)
#pragma unroll
                    for (int n = 0; n < 2; ++n) acc[a][b][m][n] = (f32x4){0.f, 0.f, 0.f, 0.f};
        cur = nxt; cA = nA; cB = nB; ++ui;
        if constexpr (ALIGN_EPI) { if (wr == 1) PG8_BAR; }
    }
    PG8_WAIT_V(0);
    if constexpr (!ALIGN_EPI) { if (wr == 0) PG8_BAR; }
    PG8_BAR;
    if constexpr (Epi::AFTER_DRAIN) { E.fused(acc, cur, wr, wc, fr, fq, lds, wid, lane); S.done(cur); }
#undef PG8_SA
#undef PG8_SB
#undef PG8_STAGE
#undef PG8_LDA
#undef PG8_LDB
#undef PG8_MMA
#undef PG8_WAIT_V
#undef PG8_WAIT_L
#undef PG8_BAR
#undef PG8_SCHED
}
}

constexpr int T = 8192, D = 2048, SEQ = 2048;
constexpr int N_IN0 = 6176, N_IN0P = 6400, LDP0 = 6144;
constexpr int N_IN1 = 10240;
constexpr int FF = 5504, FF2 = 11008;
constexpr float EPS = 1e-6f;
constexpr size_t MiB = 1u << 20;
constexpr size_t WS_WIN0 = 1 * MiB;
constexpr size_t WS_WOUT0 = WS_WIN0 + 25 * MiB;
constexpr size_t WS_WIN1 = WS_WOUT0 + 8 * MiB;
constexpr size_t WS_WOUT1 = WS_WIN1 + 40 * MiB;
constexpr size_t WS_WUP = WS_WOUT1 + 8 * MiB;
constexpr size_t WS_WDN = WS_WUP + 86 * MiB;
constexpr size_t WS_HN = WS_WDN + 43 * MiB;
constexpr size_t WS_H = WS_HN + 32 * MiB;
constexpr size_t WS_G0 = WS_H + 64 * MiB;
constexpr size_t WS_PU = WS_G0 + 1 * MiB;
constexpr size_t WS_YF = WS_PU + 172 * MiB;
constexpr size_t WS_YB = WS_YF + 32 * MiB;
constexpr size_t WS_Y = WS_YB + 32 * MiB;
constexpr size_t WS_Z = WS_Y + 32 * MiB;
constexpr size_t WS_END = WS_Z + 86 * MiB;
constexpr size_t WS_SS = WS_END;
constexpr size_t WS_EDGE = WS_END + 4 * MiB;
constexpr size_t WS_END2 = WS_EDGE + 5 * MiB;
constexpr int UP_TAIL = (32 * (FF2 / 256)) % 256;
constexpr int LDS_BYTES = 147456;

#define LAS __attribute__((address_space(3)))
typedef LAS unsigned char* ldsp;
typedef unsigned short bf16;
typedef float f32x4 __attribute__((ext_vector_type(4)));
typedef short bf16x8 __attribute__((ext_vector_type(8)));
typedef unsigned u32x4 __attribute__((ext_vector_type(4)));
typedef unsigned u32x2 __attribute__((ext_vector_type(2)));

__device__ __forceinline__ float bf2f(unsigned b) { return __builtin_bit_cast(float, b << 16); }
typedef __bf16 bf16x2_t __attribute__((ext_vector_type(2)));
typedef float f32x2_t __attribute__((ext_vector_type(2)));
__device__ __forceinline__ unsigned pk2(float lo, float hi) { f32x2_t f = {lo, hi}; bf16x2_t v = __builtin_convertvector(f, bf16x2_t); return __builtin_bit_cast(unsigned, v); }
__device__ __forceinline__ float wave_sum(float v) {
#pragma unroll
    for (int o = 1; o < 64; o <<= 1) v += __shfl_xor(v, o);
    return v;
}
#define LDS_WAIT() asm volatile("s_waitcnt lgkmcnt(0)" ::: "memory")

struct P0Mat { const float* W; bf16* WT; const float* gk; int K, N; bool glu; int ld = 0, noff = 0; };
__device__ __forceinline__ void p0_load(const P0Mat m, int item, int lane, float (&wv)[32]) {
    const int nblk = m.N / 32, kb = item / nblk, nb = item % nblk, k0 = 64 * kb, n0 = m.noff + 32 * nb, ld = m.ld ? m.ld : m.N;
    const float* wp = m.W + (size_t)(k0 + (lane >> 5)) * ld + n0 + (lane & 31);
#pragma unroll
    for (int i = 0; i < 32; ++i) wv[i] = __builtin_nontemporal_load(wp + (size_t)(2 * i) * ld);
}
__device__ __forceinline__ void p0_finish(const P0Mat m, int item, int lane, const float (&wv)[32], LAS float* scr) {
    const int nblk = m.N / 32, kb = item / nblk, nb = item % nblk, k0 = 64 * kb, n0 = m.noff + 32 * nb;
#pragma unroll
    for (int i = 0; i < 32; ++i) scr[(2 * i + (lane >> 5)) * 33 + (lane & 31)] = wv[i];
    LDS_WAIT(); asm volatile("" ::: "memory");
    const int c = lane & 7;
    float g8[8];
#pragma unroll
    for (int i = 0; i < 8; ++i) g8[i] = m.gk ? m.gk[k0 + 8 * c + i] : 1.0f;
#pragma unroll
    for (int j = 0; j < 4; ++j) { const int n = (lane >> 3) + 8 * j; const LAS float* s = scr + (8 * c) * 33 + n;
        u32x4 o; o.x = pk2(s[0 * 33] * g8[0], s[1 * 33] * g8[1]); o.y = pk2(s[2 * 33] * g8[2], s[3 * 33] * g8[3]); o.z = pk2(s[4 * 33] * g8[4], s[5 * 33] * g8[5]); o.w = pk2(s[6 * 33] * g8[6], s[7 * 33] * g8[7]);
        const int d0 = !m.glu ? n0 : (n0 < FF ? ((n0 >> 7) * 256 + (n0 & 127)) : ((((n0 - FF) >> 7) * 256) + 128 + ((n0 - FF) & 127)));
        *(u32x4*)(m.WT + (size_t)(d0 + n) * m.K + k0 + 8 * c) = o; }
    LDS_WAIT(); asm volatile("" ::: "memory");
}
__device__ __forceinline__ void p0_convert(const P0Mat m, int count, int first, int stride, int lane, LAS float* scr) {
    if (first >= count) return;
    float wa[32], wb[32];
    p0_load(m, first, lane, wa);
#pragma unroll 1
    for (int it = first; it < count; it += 2 * stride) {
        const bool h1 = it + stride < count, h2 = it + 2 * stride < count;
        if (h1) p0_load(m, it + stride, lane, wb);
        p0_finish(m, it, lane, wa, scr);
        if (h2) p0_load(m, it + 2 * stride, lane, wa);
        if (h1) p0_finish(m, it + stride, lane, wb, scr);
    }
}
__device__ __forceinline__ void p0_transpose_item(const float* W, int K, int N, bf16* WT, LAS float* scr, int item, int lane, const float* gk = nullptr, bool glu = false) {
    const P0Mat m{W, WT, gk, K, N, glu}; float wv[32]; p0_load(m, item, lane, wv); p0_finish(m, item, lane, wv, scr);
}

__device__ __forceinline__ void unpack8(const u32x4 w, float (&o)[8]) {
    o[0] = bf2f(w.x & 0xffffu); o[1] = bf2f(w.x >> 16); o[2] = bf2f(w.y & 0xffffu); o[3] = bf2f(w.y >> 16);
    o[4] = bf2f(w.z & 0xffffu); o[5] = bf2f(w.z >> 16); o[6] = bf2f(w.w & 0xffffu); o[7] = bf2f(w.w >> 16);
}
__device__ __forceinline__ void rms_rows_final(const bf16* src, const float* g, float* dstf, int gw, int NGW, int lane) {
    for (int row = gw; row < T; row += NGW) {
        const u32x4* xr = (const u32x4*)(src + (size_t)row * D) + lane;
        float v[4][8]; float ss = 0.f;
#pragma unroll
        for (int j = 0; j < 4; ++j) { unpack8(xr[64 * j], v[j]);
#pragma unroll
            for (int e = 0; e < 8; ++e) ss += v[j][e] * v[j][e]; }
        const float r = rsqrtf(wave_sum(ss) * (1.0f / D) + EPS);
#pragma unroll
        for (int j = 0; j < 4; ++j) { const int c = (lane + 64 * j) * 8; const f32x4 g0 = *(const f32x4*)(g + c), g1 = *(const f32x4*)(g + c + 4);
            f32x4 o0, o1;
#pragma unroll
            for (int e = 0; e < 4; ++e) { o0[e] = v[j][e] * r * g0[e]; o1[e] = v[j][4 + e] * r * g1[e]; }
            *(f32x4*)(dstf + (size_t)row * D + c) = o0; *(f32x4*)(dstf + (size_t)row * D + c + 4) = o1; }
    }
}
__device__ __forceinline__ void cast_rows(const float* src, bf16* dstb, float* ss, int gw, int NGW, int lane) {
    for (int row = gw; row < T; row += NGW) {
        const f32x4* xr = (const f32x4*)(src + (size_t)row * D) + lane;
        f32x4 v[8]; float q = 0.f;
#pragma unroll
        for (int j = 0; j < 8; ++j) { v[j] = xr[64 * j]; q += (v[j].x * v[j].x + v[j].y * v[j].y) + (v[j].z * v[j].z + v[j].w * v[j].w); }
        q = wave_sum(q);
#pragma unroll
        for (int j = 0; j < 8; ++j) { u32x2 w; w.x = pk2(v[j].x, v[j].y); w.y = pk2(v[j].z, v[j].w); ((u32x2*)(dstb + (size_t)row * D))[lane + 64 * j] = w; }
        if (lane < 32) ss[(size_t)row * 32 + lane] = (lane == 0) ? q : 0.f;
    }
}

template <int HD, bool SILU>
__device__ __forceinline__ void gatenorm(const bf16* __restrict__ YF, const bf16* __restrict__ YB, const bf16* __restrict__ gate, int ldg, const float* __restrict__ hg, bf16* __restrict__ Y, int gw, int NGW, int lane) {
    constexpr int NB = 4;
    for (int it0 = gw * NB; it0 < T * 8; it0 += NGW * NB) {
        u32x2 a[NB], b[NB], gq[NB]; f32x4 hgv[NB];
#pragma unroll
        for (int k = 0; k < NB; ++k) { const int item = it0 + k, tok = item >> 3, col = (item & 7) * 256 + lane * 4;
            a[k] = *(const u32x2*)(YF + (size_t)tok * D + col); b[k] = *(const u32x2*)(YB + (size_t)tok * D + col); gq[k] = *(const u32x2*)(gate + (size_t)tok * ldg + col); hgv[k] = *(const f32x4*)(hg + col); }
#pragma unroll
        for (int k = 0; k < NB; ++k) { const int item = it0 + k, tok = item >> 3, col = (item & 7) * 256 + lane * 4;
            float y[4] = { bf2f(a[k].x & 0xffffu) + bf2f(b[k].x & 0xffffu), bf2f(a[k].x >> 16) + bf2f(b[k].x >> 16), bf2f(a[k].y & 0xffffu) + bf2f(b[k].y & 0xffffu), bf2f(a[k].y >> 16) + bf2f(b[k].y >> 16) };
            float gt[4] = { bf2f(gq[k].x & 0xffffu), bf2f(gq[k].x >> 16), bf2f(gq[k].y & 0xffffu), bf2f(gq[k].y >> 16) };
            float ss = (y[0] * y[0] + y[1] * y[1]) + (y[2] * y[2] + y[3] * y[3]);
#pragma unroll
            for (int o = 1; o < HD / 4; o <<= 1) ss += __shfl_xor(ss, o);
            const float r = rsqrtf(ss * (1.0f / HD) + EPS);
            float o4[4];
#pragma unroll
            for (int e = 0; e < 4; ++e) { const float sg = __builtin_amdgcn_rcpf(1.0f + __expf(-gt[e])); const float act = SILU ? gt[e] * sg : sg; o4[e] = y[e] * r * hgv[k][e] * act; }
            u32x2 w; w.x = pk2(o4[0], o4[1]); w.y = pk2(o4[2], o4[3]);
            *(u32x2*)(Y + (size_t)tok * D + col) = w; }
    }
}


__device__ __forceinline__ void glu_fixup(const float* __restrict__ EDGE, const float* __restrict__ cw, const float* __restrict__ cb, bf16* __restrict__ Z, int pm) {
    for (int v8 = threadIdx.x; v8 < 2 * (FF / 8); v8 += 512) {
        const int which = v8 / (FF / 8), c8 = (v8 % (FF / 8)) * 8;
        if (which == 0 ? ((pm & 7) == 0) : ((pm & 7) == 7)) continue;
        const float* pp = which == 0 ? EDGE + ((size_t)(pm - 1) * 6 + 3) * FF + c8 : EDGE + ((size_t)pm * 6 + 2) * FF + c8;
        const float* pc = which == 0 ? EDGE + ((size_t)pm * 6 + 0) * FF + c8 : EDGE + ((size_t)pm * 6 + 3) * FF + c8;
        const float* pn = which == 0 ? EDGE + ((size_t)pm * 6 + 1) * FF + c8 : EDGE + ((size_t)(pm + 1) * 6 + 0) * FF + c8;
        const float* pv = EDGE + ((size_t)pm * 6 + 4 + which) * FF + c8;
        float z[8];
#pragma unroll
        for (int h = 0; h < 2; ++h) { const f32x4 a0 = *(const f32x4*)(pp + 4 * h), a1 = *(const f32x4*)(pc + 4 * h), a2 = *(const f32x4*)(pn + 4 * h), vv = *(const f32x4*)(pv + 4 * h);
            const f32x4 k0 = *(const f32x4*)(cw + c8 + 4 * h), k1 = *(const f32x4*)(cw + FF + c8 + 4 * h), k2 = *(const f32x4*)(cw + 2 * FF + c8 + 4 * h), bb = *(const f32x4*)(cb + c8 + 4 * h);
            const f32x4 c = bb + k0 * a0 + k1 * a1 + k2 * a2;
            const pg8::f32x2 g0 = pg8::gelu_pk((pg8::f32x2){c[0], c[1]}), g1 = pg8::gelu_pk((pg8::f32x2){c[2], c[3]});
            z[4 * h] = g0.x * vv[0]; z[4 * h + 1] = g0.y * vv[1]; z[4 * h + 2] = g1.x * vv[2]; z[4 * h + 3] = g1.y * vv[3]; }
        u32x4 w; w.x = pk2(z[0], z[1]); w.y = pk2(z[2], z[3]); w.z = pk2(z[4], z[5]); w.w = pk2(z[6], z[7]);
        *(u32x4*)(Z + (size_t)(pm * 256 + (which ? 255 : 0)) * FF + c8) = w;
    }
    asm volatile("s_waitcnt vmcnt(0)" ::: "memory"); __syncthreads();
}

template <int KS> __device__ __forceinline__ void ld_frag(bf16x8 (&f)[KS], ldsp X, int xs, int r0, int fr, int fq) {
    ldsp p = X + (r0 + fr) * xs + fq * 16;
#pragma unroll
    for (int k = 0; k < KS; ++k) f[k] = *(const LAS bf16x8*)(p + k * 64);
}
template <int KS> __device__ __forceinline__ f32x4 mma_frag(const bf16x8 (&a)[KS], const bf16x8 (&b)[KS], f32x4 acc) {
#pragma unroll
    for (int k = 0; k < KS; ++k) acc = __builtin_amdgcn_mfma_f32_16x16x32_bf16(a[k], b[k], acc, 0, 0, 0);
    return acc;
}
constexpr int QS = 272, TS = 144;


__device__ __forceinline__ void gate_gemm(ldsp lds, const bf16* HN, const bf16* Wg, const float* ss, const float* bias, float* G, int blk, int nblk) {
    const int tid = threadIdx.x, lane = tid & 63, wid = __builtin_amdgcn_readfirstlane(tid >> 6), fr = lane & 15, fq = lane >> 4;
    LAS float* red = (LAS float*)lds;
    for (int rb = blk; rb < T / 32; rb += nblk) {
        const int R0 = rb * 32, k0 = wid * 256;
        f32x4 acc[2][2];
#pragma unroll
        for (int a = 0; a < 2; ++a)
#pragma unroll
            for (int b = 0; b < 2; ++b) acc[a][b] = (f32x4){0.f, 0.f, 0.f, 0.f};
        bf16x8 fa[2][8], fb[2][8];
#pragma unroll
        for (int t = 0; t < 2; ++t)
#pragma unroll
            for (int k = 0; k < 8; ++k) { fa[t][k] = *(const bf16x8*)(HN + (size_t)(R0 + t * 16 + fr) * D + k0 + k * 32 + fq * 8); fb[t][k] = *(const bf16x8*)(Wg + (size_t)(t * 16 + fr) * D + k0 + k * 32 + fq * 8); }
#pragma unroll
        for (int k = 0; k < 8; ++k)
#pragma unroll
            for (int a = 0; a < 2; ++a)
#pragma unroll
                for (int b = 0; b < 2; ++b) acc[a][b] = __builtin_amdgcn_mfma_f32_16x16x32_bf16(fa[a][k], fb[b][k], acc[a][b], 0, 0, 0);
        __syncthreads();
#pragma unroll
        for (int a = 0; a < 2; ++a)
#pragma unroll
            for (int b = 0; b < 2; ++b)
#pragma unroll
                for (int j = 0; j < 4; ++j) red[(wid * 32 + a * 16 + fq * 4 + j) * 33 + b * 16 + fr] = acc[a][b][j];
        __syncthreads();
#pragma unroll
        for (int e = 0; e < 2; ++e) { const int o = tid + 512 * e, row = o >> 5, col = o & 31; float v = 0.f;
#pragma unroll
            for (int w = 0; w < 8; ++w) v += red[(w * 32 + row) * 33 + col];
            const float rs = rsqrtf(ss[(size_t)(R0 + row) * 32] * (1.0f / 2048.0f) + 1e-6f);
            G[(size_t)(R0 + row) * 32 + col] = v * rs + bias[col]; }
    }
    __syncthreads();
}

__device__ __forceinline__ void mlstm_phase(ldsp lds, const bf16* P, const float* G, bf16* YF, bf16* YB, int vcu, int G_) {
    const int tid = threadIdx.x, lane = tid & 63, wid = __builtin_amdgcn_readfirstlane(tid >> 6), fr = lane & 15, fq = lane >> 4;
    ldsp sQ = lds, sK = sQ + 64 * QS, sKt = sK + 64 * QS, sVt = sKt + 128 * TS, sP = sVt + 80 * TS, sC = sP + 64 * TS;
    LAS float* sDen = (LAS float*)(sC + 80 * QS);
    LAS float* sPre = sDen + 64;
    LAS float* sCh = sPre + 32 * 192;
    LAS float* sMst = sCh + 64;
    for (int unit = vcu; unit < 256; unit += G_) {
        const int slice = unit & 3, dir = (unit >> 2) & 1, h = (unit >> 3) & 7, b = unit >> 6;
        bf16* Yo = dir ? YB : YF;
#define ML_TOK(ci, i) (b * SEQ + (dir ? (SEQ - 1 - ((ci) * 64 + (i))) : ((ci) * 64 + (i))))
        __syncthreads();
        for (int i = tid; i < 80 * QS / 4; i += 512) ((LAS unsigned*)sC)[i] = 0u;
        for (int i = tid; i < 16 * TS / 4; i += 512) ((LAS unsigned*)(sVt + 64 * TS))[i] = (i < TS / 4) ? 0x3f803f80u : 0u;
        {
            float gi[4], gf[4];
#pragma unroll
            for (int c = 0; c < 4; ++c) { const float* gp = G + (size_t)ML_TOK(wid * 4 + c, lane) * 32 + dir * 16 + h; gi[c] = gp[0]; gf[c] = gp[8]; }
#pragma unroll
            for (int c = 0; c < 4; ++c) {
                const float lf = (gf[c] >= 0.f) ? -log1pf(__expf(-gf[c])) : gf[c] - log1pf(__expf(gf[c]));
                float bc = lf;
#pragma unroll
                for (int o = 1; o < 64; o <<= 1) { const float t = __shfl_up(bc, o); if (lane >= o) bc += t; }
                const float u = gi[c] - bc; float pm = u;
#pragma unroll
                for (int o = 1; o < 64; o <<= 1) { const float t = __shfl_up(pm, o); if (lane >= o) pm = fmaxf(pm, t); }
                LAS float* pp = sPre + (wid * 4 + c) * 192;
                pp[lane] = bc; pp[64 + lane] = u; pp[128 + lane] = pm;
                if (lane == 63) { sCh[(wid * 4 + c) * 2] = bc; sCh[(wid * 4 + c) * 2 + 1] = pm; }
            }
        }
        __syncthreads();
        if (wid == 0) { float m = 0.f;
#pragma unroll 1
            for (int c = 0; c < 32; ++c) { if (lane == 0) sMst[c] = m; const float gt = sCh[2 * c], p63 = sCh[2 * c + 1]; m = gt + fmaxf(m, p63); } }
        f32x4 CT[5];
#pragma unroll
        for (int n = 0; n < 5; ++n) CT[n] = (f32x4){0.f, 0.f, 0.f, 0.f};
        u32x4 rq[2], rk[2]; unsigned rv[8];
#define ML_LOAD(ci) do { \
            _Pragma("unroll") for (int j = 0; j < 2; ++j) { const int id = tid + 512 * j, row = id >> 4, c16 = id & 15; const bf16* rp = P + (size_t)ML_TOK(ci, row) * LDP0 + h * 128 + c16 * 8; \
                rq[j] = *(const u32x4*)rp; rk[j] = *(const u32x4*)(rp + 1024); } \
            _Pragma("unroll") for (int e = 0; e < 8; ++e) rv[e] = P[(size_t)ML_TOK(ci, wid * 8 + e) * LDP0 + 2048 + h * 256 + slice * 64 + lane]; } while (0)
        ML_LOAD(0);
#pragma unroll 1
        for (int ci = 0; ci < 32; ++ci) {
            const LAS float* pp = sPre + ci * 192;
#pragma unroll
            for (int j = 0; j < 2; ++j) { const int id = tid + 512 * j, row = id >> 4, c16 = id & 15; *(LAS u32x4*)(sQ + row * QS + c16 * 16) = rq[j]; *(LAS u32x4*)(sK + row * QS + c16 * 16) = rk[j]; }
            { u32x4 w; w.x = rv[0] | (rv[1] << 16); w.y = rv[2] | (rv[3] << 16); w.z = rv[4] | (rv[5] << 16); w.w = rv[6] | (rv[7] << 16); *(LAS u32x4*)(sVt + lane * TS + wid * 16) = w; }
            if (ci + 1 < 32) ML_LOAD(ci + 1);
            __syncthreads();
            const float m_st = sMst[ci], mrel = fmaxf(m_st, sCh[2 * ci + 1]);
            const int w3 = wid & 3, mt0 = wid >> 2, mt1 = mt0 + 2;
            f32x4 acc[3];
            {
                bf16x8 fK[4], fa0[4], fa1[4];
                ld_frag<4>(fK, sK, QS, w3 * 16, fr, fq);
                ld_frag<4>(fa0, sQ, QS, mt0 * 16, fr, fq); ld_frag<4>(fa1, sQ, QS, mt1 * 16, fr, fq);
                const float cc = pp[64 + w3 * 16 + fr];
                const f32x4 pmA = *(const LAS f32x4*)(pp + 128 + mt0 * 16 + fq * 4), pmB = *(const LAS f32x4*)(pp + 128 + mt1 * 16 + fq * 4), pmC = *(const LAS f32x4*)(pp + 128 + w3 * 16 + fq * 4);
                const f32x4 u0 = *(const LAS f32x4*)(pp + 64 + wid * 8), u1 = *(const LAS f32x4*)(pp + 64 + wid * 8 + 4);
                unsigned kk[8];
#pragma unroll
                for (int e = 0; e < 8; ++e) kk[e] = *(const LAS unsigned*)(sK + (wid * 8 + e) * QS + lane * 4);
                const f32x4 z4 = (f32x4){0.f, 0.f, 0.f, 0.f};
                f32x4 s0 = z4, s1 = z4;
                if (w3 <= mt0) s0 = mma_frag<4>(fa0, fK, s0);
                s1 = mma_frag<4>(fa1, fK, s1);
                { bf16x8 fQ[4], fb0[4], fb1[4];
                  ld_frag<4>(fQ, sQ, QS, w3 * 16, fr, fq); ld_frag<4>(fb0, sC, QS, mt0 * 16, fr, fq); ld_frag<4>(fb1, sC, QS, mt1 * 16, fr, fq);
                  acc[0] = mma_frag<4>(fQ, fb0, z4); acc[1] = mma_frag<4>(fQ, fb1, z4); acc[2] = z4;
                  if (wid < 4) { bf16x8 fb2[4]; ld_frag<4>(fb2, sC, QS, 64, fr, fq); acc[2] = mma_frag<4>(fQ, fb2, z4); } }
                const int scol = w3 * 16 + fr;
#pragma unroll
                for (int j = 0; j < 4; ++j) { const int t0 = mt0 * 16 + fq * 4 + j, t1 = mt1 * 16 + fq * 4 + j;
                    const float e0 = (scol <= t0) ? s0[j] * __expf(cc - fmaxf(pmA[j], m_st)) : 0.f, e1 = (scol <= t1) ? s1[j] * __expf(cc - fmaxf(pmB[j], m_st)) : 0.f;
                    *(LAS unsigned short*)(sP + t0 * TS + scol * 2) = (unsigned short)(pk2(e0, 0.f) & 0xffffu); *(LAS unsigned short*)(sP + t1 * TS + scol * 2) = (unsigned short)(pk2(e1, 0.f) & 0xffffu); }
                f32x4 wi;
#pragma unroll
                for (int j = 0; j < 4; ++j) wi[j] = __expf(m_st - fmaxf(pmC[j], m_st));
                acc[0] *= wi; acc[1] *= wi; acc[2] *= wi;
                unsigned lo[8], hi[8];
#pragma unroll
                for (int e = 0; e < 8; ++e) { const float w = __expf((e < 4 ? u0[e & 3] : u1[e & 3]) - mrel); lo[e] = pk2(bf2f(kk[e] & 0xffffu) * w, 0.f) & 0xffffu; hi[e] = pk2(bf2f(kk[e] >> 16) * w, 0.f) & 0xffffu; }
                u32x4 a, c; a.x = lo[0] | (lo[1] << 16); a.y = lo[2] | (lo[3] << 16); a.z = lo[4] | (lo[5] << 16); a.w = lo[6] | (lo[7] << 16);
                c.x = hi[0] | (hi[1] << 16); c.y = hi[2] | (hi[3] << 16); c.z = hi[4] | (hi[5] << 16); c.w = hi[6] | (hi[7] << 16);
                *(LAS u32x4*)(sKt + (2 * lane) * TS + wid * 16) = a; *(LAS u32x4*)(sKt + (2 * lane + 1) * TS + wid * 16) = c;
            }
            __syncthreads();
            {
                bf16x8 fP[2], fKt[2], fV[5][2];
                ld_frag<2>(fP, sP, TS, w3 * 16, fr, fq); ld_frag<2>(fKt, sKt, TS, wid * 16, fr, fq);
#pragma unroll
                for (int n = 0; n < 5; ++n) ld_frag<2>(fV[n], sVt, TS, n * 16, fr, fq);
                if (mt0 == 0) { acc[0] = mma_frag<2>(fP, fV[0], acc[0]); acc[1] = mma_frag<2>(fP, fV[2], acc[1]); }
                else { acc[0] = mma_frag<2>(fP, fV[1], acc[0]); acc[1] = mma_frag<2>(fP, fV[3], acc[1]); }
                if (wid < 4) acc[2] = mma_frag<2>(fP, fV[4], acc[2]);
                const float dec = __expf(m_st - mrel);
#pragma unroll
                for (int n = 0; n < 5; ++n) { CT[n] *= dec; CT[n] = mma_frag<2>(fKt, fV[n], CT[n]); }
                if (wid < 4 && fr == 0) *(LAS f32x4*)(sDen + wid * 16 + fq * 4) = acc[2];
#pragma unroll
                for (int n = 0; n < 5; ++n) { u32x2 w; w.x = pk2(CT[n][0], CT[n][1]); w.y = pk2(CT[n][2], CT[n][3]); *(LAS u32x2*)(sC + (n * 16 + fr) * QS + (wid * 16 + fq * 4) * 2) = w; }
            }
            __syncthreads();
            { const f32x4 pm4 = *(const LAS f32x4*)(pp + 128 + w3 * 16 + fq * 4), bc4 = *(const LAS f32x4*)(pp + w3 * 16 + fq * 4), dn4 = *(const LAS f32x4*)(sDen + w3 * 16 + fq * 4);
              bf16* yp = Yo + (size_t)ML_TOK(ci, w3 * 16 + fq * 4) * D + h * 256 + slice * 64 + mt0 * 16 + fr;
              const long ystep = dir ? -(long)D : (long)D;
#pragma unroll
              for (int j = 0; j < 4; ++j) { const float rdn = __builtin_amdgcn_rcpf(fmaxf(fabsf(dn4[j]), __expf(-(bc4[j] + fmaxf(pm4[j], m_st)))));
                  yp[j * ystep] = (bf16)(pk2(acc[0][j] * rdn, 0.f) & 0xffffu); yp[j * ystep + 32] = (bf16)(pk2(acc[1][j] * rdn, 0.f) & 0xffffu); } }
        }
#undef ML_LOAD
#undef ML_TOK
    }
}

__device__ __forceinline__ void hgrn_phase(ldsp lds, const bf16* P, bf16* YF, bf16* YB, int vcu, int G_) {
    const int tid = threadIdx.x, lane = tid & 63, wid = __builtin_amdgcn_readfirstlane(tid >> 6), fr = lane & 15, fq = lane >> 4;
    ldsp sQs = lds, sQm = sQs + 64 * QS, sKm = sQm + 64 * QS, sKet = sKm + 64 * QS, sVt = sKet + 128 * TS, sP = sVt + 64 * TS, sS = sP + 64 * TS;
    LAS float* sSeg = (LAS float*)(sS + 64 * QS);
    LAS float* sDec = sSeg + 8 * 128;
    for (int unit = vcu; unit < 256; unit += G_) {
        const int slice = unit & 1, dir = (unit >> 1) & 1, h = (unit >> 2) & 15, b = unit >> 6;
        bf16* Yo = dir ? YB : YF;
        __syncthreads();
        for (int i = tid; i < 64 * QS / 4; i += 512) ((LAS unsigned*)sS)[i] = 0u;
        f32x4 ST[4];
#pragma unroll
        for (int n = 0; n < 4; ++n) ST[n] = (f32x4){0.f, 0.f, 0.f, 0.f};
        unsigned rq[8], rl[8], rv[8];
#define HG_TOK(ci, i) (b * SEQ + (dir ? (SEQ - 1 - ((ci) * 64 + (i))) : ((ci) * 64 + (i))))
#define HG_LOAD(ci) do { \
            _Pragma("unroll") for (int e = 0; e < 8; ++e) { const bf16* rp = P + (size_t)HG_TOK(ci, wid * 8 + e) * N_IN1 + h * 128; \
                rq[e] = *(const unsigned*)(rp + 2 * lane); rl[e] = *(const unsigned*)(rp + 6144 + dir * 2048 + 2 * lane); rv[e] = rp[2048 + slice * 64 + lane]; } } while (0)
        HG_LOAD(0);
        const int w3 = wid & 3, mt0 = wid >> 2, mt1 = mt0 + 2;
#pragma unroll 1
        for (int ci = 0; ci < 32; ++ci) {
            float l0[8], l1[8], c0[8], c1[8]; unsigned qc[8];
            { float a0 = 0.f, a1 = 0.f;
#pragma unroll
              for (int e = 0; e < 8; ++e) { l0[e] = bf2f(rl[e] & 0xffffu); l1[e] = bf2f(rl[e] >> 16); a0 += l0[e]; a1 += l1[e]; c0[e] = a0; c1[e] = a1; qc[e] = rq[e]; }
              *(LAS f32x2_t*)(sSeg + wid * 128 + 2 * lane) = (f32x2_t){a0, a1}; }
            { u32x4 w; w.x = rv[0] | (rv[1] << 16); w.y = rv[2] | (rv[3] << 16); w.z = rv[4] | (rv[5] << 16); w.w = rv[6] | (rv[7] << 16); *(LAS u32x4*)(sVt + lane * TS + wid * 16) = w; }
            if (ci + 1 < 32) HG_LOAD(ci + 1);
            __syncthreads();
            { float off0 = 0.f, off1 = 0.f, mid0 = 0.f, mid1 = 0.f, end0 = 0.f, end1 = 0.f;
              f32x2_t sg[8];
#pragma unroll
              for (int s = 0; s < 8; ++s) sg[s] = *(const LAS f32x2_t*)(sSeg + s * 128 + 2 * lane);
#pragma unroll
              for (int s = 0; s < 8; ++s) { if (s < wid) { off0 += sg[s].x; off1 += sg[s].y; } if (s < 4) { mid0 += sg[s].x; mid1 += sg[s].y; } end0 += sg[s].x; end1 += sg[s].y; }
              if (wid == 0) *(LAS f32x2_t*)(sDec + 2 * lane) = (f32x2_t){__expf(end0), __expf(end1)};
              unsigned lo[8], hi[8];
              const float im0 = __expf(-mid0), im1 = __expf(-mid1), em0 = __expf(end0 - mid0), em1 = __expf(end1 - mid1);
#pragma unroll
              for (int e = 0; e < 8; ++e) { const int t = wid * 8 + e; const float b0 = c0[e] + off0, b1 = c1[e] + off1;
                  const float q0 = bf2f(qc[e] & 0xffffu), q1 = bf2f(qc[e] >> 16);
                  const float k0 = 1.0f - __expf(l0[e]), k1 = 1.0f - __expf(l1[e]);
                  const float qs0 = q0 * __expf(b0), qs1 = q1 * __expf(b1), km0 = k0 * __expf(mid0 - b0), km1 = k1 * __expf(mid1 - b1);
                  *(LAS unsigned*)(sQs + t * QS + lane * 4) = pk2(qs0, qs1);
                  *(LAS unsigned*)(sQm + t * QS + lane * 4) = pk2(qs0 * im0, qs1 * im1);
                  *(LAS unsigned*)(sKm + t * QS + lane * 4) = pk2(km0, km1);
                  lo[e] = pk2(km0 * em0, 0.f) & 0xffffu; hi[e] = pk2(km1 * em1, 0.f) & 0xffffu; }
              u32x4 a, c; a.x = lo[0] | (lo[1] << 16); a.y = lo[2] | (lo[3] << 16); a.z = lo[4] | (lo[5] << 16); a.w = lo[6] | (lo[7] << 16);
              c.x = hi[0] | (hi[1] << 16); c.y = hi[2] | (hi[3] << 16); c.z = hi[4] | (hi[5] << 16); c.w = hi[6] | (hi[7] << 16);
              *(LAS u32x4*)(sKet + (2 * lane) * TS + wid * 16) = a; *(LAS u32x4*)(sKet + (2 * lane + 1) * TS + wid * 16) = c; }
            __syncthreads();
            f32x4 acc[2];
            { const f32x4 z4 = (f32x4){0.f, 0.f, 0.f, 0.f};
              f32x4 s0 = z4, s1 = z4;
              { bf16x8 fK[4], fa0[4], fa1[4];
                ld_frag<4>(fK, sKm, QS, w3 * 16, fr, fq); ld_frag<4>(fa0, sQm, QS, mt0 * 16, fr, fq); ld_frag<4>(fa1, sQm, QS, mt1 * 16, fr, fq);
                if (w3 <= mt0) s0 = mma_frag<4>(fa0, fK, s0);
                s1 = mma_frag<4>(fa1, fK, s1); }
              { bf16x8 fQ[4], fb0[4], fb1[4];
                ld_frag<4>(fQ, sQs, QS, w3 * 16, fr, fq); ld_frag<4>(fb0, sS, QS, mt0 * 16, fr, fq); ld_frag<4>(fb1, sS, QS, mt1 * 16, fr, fq);
                acc[0] = mma_frag<4>(fQ, fb0, z4); acc[1] = mma_frag<4>(fQ, fb1, z4); }
              const int scol = w3 * 16 + fr;
#pragma unroll
              for (int j = 0; j < 4; ++j) { const int t0 = mt0 * 16 + fq * 4 + j, t1 = mt1 * 16 + fq * 4 + j;
                  *(LAS unsigned short*)(sP + t0 * TS + scol * 2) = (unsigned short)(pk2((scol <= t0) ? s0[j] : 0.f, 0.f) & 0xffffu);
                  *(LAS unsigned short*)(sP + t1 * TS + scol * 2) = (unsigned short)(pk2((scol <= t1) ? s1[j] : 0.f, 0.f) & 0xffffu); } }
            __syncthreads();
            { bf16x8 fP[2], fKt[2], fV[4][2];
              ld_frag<2>(fP, sP, TS, w3 * 16, fr, fq); ld_frag<2>(fKt, sKet, TS, wid * 16, fr, fq);
#pragma unroll
              for (int n = 0; n < 4; ++n) ld_frag<2>(fV[n], sVt, TS, n * 16, fr, fq);
              const f32x4 dec = *(const LAS f32x4*)(sDec + wid * 16 + fq * 4);
              if (mt0 == 0) { acc[0] = mma_frag<2>(fP, fV[0], acc[0]); acc[1] = mma_frag<2>(fP, fV[2], acc[1]); }
              else { acc[0] = mma_frag<2>(fP, fV[1], acc[0]); acc[1] = mma_frag<2>(fP, fV[3], acc[1]); }
#pragma unroll
              for (int n = 0; n < 4; ++n) { ST[n] *= dec; ST[n] = mma_frag<2>(fKt, fV[n], ST[n]); }
#pragma unroll
              for (int n = 0; n < 4; ++n) { u32x2 w; w.x = pk2(ST[n][0], ST[n][1]); w.y = pk2(ST[n][2], ST[n][3]); *(LAS u32x2*)(sS + (n * 16 + fr) * QS + (wid * 16 + fq * 4) * 2) = w; } }
            { bf16* yp = Yo + (size_t)HG_TOK(ci, w3 * 16 + fq * 4) * D + h * 128 + slice * 64 + mt0 * 16 + fr;
              const long ystep = dir ? -(long)D : (long)D;
#pragma unroll
              for (int j = 0; j < 4; ++j) { yp[j * ystep] = (bf16)(pk2(acc[0][j], 0.f) & 0xffffu); yp[j * ystep + 32] = (bf16)(pk2(acc[1][j], 0.f) & 0xffffu); } }
            __syncthreads();
        }
#undef HG_LOAD
#undef HG_TOK
    }
}

#define XB_TMO      128
#define XB_XCNT(j)  (256  + 64 * (j))
#define XB_XSUB(j)  (1280 + 64 * (j))
#define XB_XGEN(j)  (2304 + 64 * (j))
#define XB_TOP      3328
#define XB_TOPGEN   3392
#define XCD_BAR_WORDS 3456
#define XB_SPIN_CAP (1u << 18)

__device__ __forceinline__ unsigned xb_ld(unsigned* p)              { return __hip_atomic_load(p, __ATOMIC_RELAXED, __HIP_MEMORY_SCOPE_AGENT); }
__device__ __forceinline__ unsigned xb_add(unsigned* p, unsigned v) { return __hip_atomic_fetch_add(p, v, __ATOMIC_RELAXED, __HIP_MEMORY_SCOPE_AGENT); }
__device__ __forceinline__ unsigned xb_xcc_id() { return (unsigned)__builtin_amdgcn_s_getreg((3 << 11) | 20) & 0xFu; }
#define XB_SPIN(cond, bar) do { unsigned _sp = 0; while (cond) { __builtin_amdgcn_s_sleep(1); \
    if ((++_sp & 255u) == 0u) { if (xb_ld(&(bar)[XB_TMO])) break; if (_sp > XB_SPIN_CAP) { atomicAdd(&(bar)[XB_TMO], 1u); break; } } } } while (0)

struct XcdBarrier {
    unsigned* bar; unsigned x;
    volatile LAS unsigned* st;
};

__device__ __forceinline__ XcdBarrier xcd_barrier_post(unsigned* bar, volatile LAS unsigned* st) {
    XcdBarrier b; b.bar = bar; b.x = xb_xcc_id(); b.st = st;
    if (threadIdx.x == 0) (void)xb_add(&bar[XB_XCNT(b.x)], 1u);
    return b;
}
__device__ __forceinline__ void xcd_barrier_complete(unsigned* bar, unsigned x, unsigned& nloc, unsigned& nx) {
    const unsigned G = gridDim.x * gridDim.y * gridDim.z;
    unsigned sum, cnt, mine, sp = 0u;
    for (;;) {
        sum = 0u; cnt = 0u; mine = 0u;
#pragma unroll
        for (unsigned j = 0; j < 16; ++j) { const unsigned c = xb_ld(&bar[XB_XCNT(j)]); sum += c; cnt += (c > 0u) ? 1u : 0u; mine = (j == x) ? c : mine; }
        if (sum == G) break;
        __builtin_amdgcn_s_sleep(1);
        if ((++sp & 255u) == 0u) { if (xb_ld(&bar[XB_TMO])) break; if (sp > XB_SPIN_CAP) { atomicAdd(&bar[XB_TMO], 1u); break; } }
    }
    nloc = mine > 0u ? mine : 1u; nx = cnt > 0u ? cnt : 1u;
}

__device__ __forceinline__ void xcd_barrier(const XcdBarrier& b) {
    asm volatile("s_waitcnt vmcnt(0)" ::: "memory");
    __syncthreads();
    if (threadIdx.x == 0) {
        unsigned* bar = b.bar;
        __builtin_amdgcn_s_waitcnt(0);
        unsigned nloc = b.st[0], nx = b.st[1];
        if (nloc == 0u) { xcd_barrier_complete(bar, b.x, nloc, nx); b.st[0] = nloc; b.st[1] = nx; }
        const unsigned old = xb_add(&bar[XB_XSUB(b.x)], 1u);
        const unsigned gen = old / nloc;
        if (old + 1u == (gen + 1u) * nloc) {
            __builtin_amdgcn_fence(__ATOMIC_RELEASE, "agent");
            asm volatile("s_waitcnt vmcnt(0)" ::: "memory");
            const unsigned og = xb_add(&bar[XB_TOP], 1u);
            const unsigned tg = og / nx;
            if (og + 1u == (tg + 1u) * nx) xb_add(&bar[XB_TOPGEN], 1u);
            else XB_SPIN(xb_ld(&bar[XB_TOPGEN]) == tg, bar);
            __builtin_amdgcn_fence(__ATOMIC_ACQUIRE, "agent");
            xb_add(&bar[XB_XGEN(b.x)], 1u);
            asm volatile("s_waitcnt vmcnt(0)" ::: "memory");
        } else {
            XB_SPIN(xb_ld(&bar[XB_XGEN(b.x)]) == gen, bar);
            __builtin_amdgcn_fence(__ATOMIC_ACQUIRE, "agent");
            asm volatile("s_waitcnt vmcnt(0)" ::: "memory");
        }
    }
    __syncthreads();
}

struct Args { const float* in[16]; float* out; unsigned char* ws; };
__global__ void __launch_bounds__(512, 2) fwd_megakernel(Args a) {
    extern __shared__ __attribute__((aligned(16))) unsigned char lds_raw[];
    cg::grid_group grid = cg::this_grid();
    ldsp lds = (ldsp)lds_raw;
    const int tid = threadIdx.x, lane = tid & 63, wave = __builtin_amdgcn_readfirstlane(tid >> 6);
    const int G_ = gridDim.x, bx = blockIdx.x;
    const int vcu = (G_ % 8 == 0) ? (bx % 8) * (G_ / 8) + bx / 8 : bx;
    const int gw = vcu * 8 + wave, NGW = G_ * 8;
    unsigned char* ws = a.ws;
    volatile LAS unsigned* MISC = (volatile LAS unsigned*)(lds + 131072 + 320);
    if (tid < 32) MISC[tid] = 0u;
    __syncthreads();
    XcdBarrier bar = xcd_barrier_post((unsigned*)ws, MISC + 8);
    if (ws == nullptr) grid.sync();
    const float* x = a.in[0]; const float* norm_mix_g = a.in[1]; const float* norm_ffn_g = a.in[2];
    const float* ml_w_in = a.in[3]; const float* ml_b_gate = a.in[4]; const float* ml_head_g = a.in[5]; const float* ml_w_out = a.in[6];
    const float* hg_w_in = a.in[7]; const float* hg_lb = a.in[8]; const float* hg_head_g = a.in[9]; const float* hg_w_out = a.in[10];
    const float* ffn_w_up = a.in[11]; const float* ffn_conv_w = a.in[12]; const float* ffn_conv_b = a.in[13]; const float* ffn_w_down = a.in[14]; const float* final_g = a.in[15];
    bf16* Win0 = (bf16*)(ws + WS_WIN0); bf16* Wout0 = (bf16*)(ws + WS_WOUT0); bf16* Win1 = (bf16*)(ws + WS_WIN1); bf16* Wout1 = (bf16*)(ws + WS_WOUT1);
    bf16* Wup = (bf16*)(ws + WS_WUP); bf16* Wdn = (bf16*)(ws + WS_WDN);
    float* SS = (float*)(ws + WS_SS); float* EDGE = (float*)(ws + WS_EDGE);
    bf16* HN = (bf16*)(ws + WS_HN); float* H = (float*)(ws + WS_H); float* G0 = (float*)(ws + WS_G0);
    bf16* PU = (bf16*)(ws + WS_PU); bf16* YF = (bf16*)(ws + WS_YF); bf16* YB = (bf16*)(ws + WS_YB); bf16* Y = (bf16*)(ws + WS_Y); bf16* Z = (bf16*)(ws + WS_Z);
#ifndef PHMASK
#define PHMASK 0xffff
#endif
#define PH(k) ((PHMASK >> (k)) & 1)
#define GSYNC() xcd_barrier(bar)

    if (PH(0)) {
        LAS float* scr = (LAS float*)(lds + wave * 16384);
        constexpr int I0 = 32 * (N_IN0 / 32), I1 = 32 * 64, I2 = 32 * (N_IN1 / 32), I3 = 32 * 64, I4 = 32 * (FF2 / 32), I5 = (FF / 64) * 64;
        constexpr int NITEMS = I0 + I1 + I4;
        for (int it = gw; it < NITEMS; it += NGW) {
            int r = it;
            if (r < I4) { p0_transpose_item(ffn_w_up, D, FF2, Wup, scr, r, lane, norm_ffn_g, true); continue; } r -= I4;
            if (r < I1) { p0_transpose_item(ml_w_out, D, D, Wout0, scr, r, lane); continue; } r -= I1;
            p0_transpose_item(ml_w_in, D, N_IN0, Win0, scr, r, lane, norm_mix_g);
        }
        cast_rows(x, HN, SS, gw, NGW, lane);
    }
    GSYNC();
#define RUN_LAYER(layer) do { \
        if (PH(1) && layer == 0) { \
            gate_gemm(lds, HN, Win0 + (size_t)LDP0 * D, SS, ml_b_gate, G0, bx, G_); \
            pg8::Gemm g{HN, Win0, T, LDP0, D}; pg8::StaticOrder S; S.init(T, LDP0, G_, bx); \
            pg8::EpiX<1> E{PU, LDP0, G0, ml_b_gate, SS + (size_t)2 * layer * T * 32}; \
            pg8::gemm_phase<pg8::EpiX<1>, pg8::StaticOrder, true, true>(lds, g, S, E); \
        } else if (PH(2)) { \
            pg8::Gemm g{HN, Win1, T, N_IN1, D}; pg8::StaticOrder S; S.init(T, N_IN1, G_, bx); \
            pg8::EpiX<2> E{PU, N_IN1, nullptr, hg_lb, SS + (size_t)2 * layer * T * 32}; \
            pg8::gemm_phase<pg8::EpiX<2>, pg8::StaticOrder, true, true>(lds, g, S, E); \
        } \
        GSYNC(); \
        if (layer == 0) { if (PH(3)) mlstm_phase(lds, PU, G0, YF, YB, vcu, G_); } else if (PH(4)) hgrn_phase(lds, PU, YF, YB, vcu, G_); \
        GSYNC(); \
        if (!PH(5)) {} else if (layer == 0) gatenorm<256, false>(YF, YB, PU + 4096, LDP0, ml_head_g, Y, gw, NGW, lane); \
        else gatenorm<128, true>(YF, YB, PU + 4096, N_IN1, hg_head_g, Y, gw, NGW, lane); \
        GSYNC(); \
        if (PH(6)) { \
            pg8::Gemm g{Y, layer == 0 ? Wout0 : Wout1, T, D, D}; pg8::StaticOrder S; S.init(T, D, G_, bx); \
            if (layer == 0) { pg8::EpiRes<true, true> E{x, D, HN, SS + (size_t)T * 32}; pg8::gemm_phase<pg8::EpiRes<true, true>, pg8::StaticOrder, true, true>(lds, g, S, E); } \
            else { pg8::EpiRes<false, true> E{nullptr, D, HN, SS + (size_t)3 * T * 32}; pg8::gemm_phase<pg8::EpiRes<false, true>, pg8::StaticOrder, true, true>(lds, g, S, E); } \
        } \
        GSYNC(); \
        if (PH(7)) { \
            pg8::Gemm g{HN, Wup + (size_t)layer * FF2 * D, T, FF2, D}; \
            pg8::EpiGLU E{Z, EDGE, ffn_conv_w + (size_t)layer * 3 * FF, ffn_conv_b + (size_t)layer * FF, SS + (size_t)(2 * layer + 1) * T * 32, (LAS float*)(lds + 131072 + 2048)}; \
            const int tail0 = (G_ > UP_TAIL) ? UP_TAIL : 0; \
            constexpr int J3 = 32 * 64, J5 = (FF / 64) * 64, NT_MAIN = 32 * 40, NT_ALL = 32 * (FF2 / 256); \
            constexpr int FE = 40 * 128;                         \
            const float* wu1 = ffn_w_up + (size_t)D * FF2; bf16* wu1t = Wup + (size_t)FF2 * D; \
            if (layer == 0) { \
                pg8::StaticOrder S; S.init(T, FF2, G_, bx); \
                pg8::gemm_phase<pg8::EpiGLU, pg8::StaticOrder, true, true>(lds, g, S, E); \
                if (bx >= tail0) {     \
                    { int tid3 = threadIdx.x; asm volatile("" : "+v"(tid3)); const int lane3 = tid3 & 63, wave3 = __builtin_amdgcn_readfirstlane(tid3 >> 6); \
                    const int tw = (bx - tail0) * 8 + wave3, tn = (G_ - tail0) * 8; LAS float* scr = (LAS float*)(lds + wave3 * 16384); \
                    p0_convert(P0Mat{wu1, wu1t, norm_ffn_g + D, D, FF - FE, true, FF2, FE}, 32 * ((FF - FE) / 32), tw, tn, lane3, scr); \
                    p0_convert(P0Mat{wu1, wu1t, norm_ffn_g + D, D, FF - FE, true, FF2, FF + FE}, 32 * ((FF - FE) / 32), tw, tn, lane3, scr); \
                    p0_convert(P0Mat{hg_w_out, Wout1, nullptr, D, D, false}, J3, tw, tn, lane3, scr); \
                    p0_convert(P0Mat{hg_w_in, Win1, norm_mix_g + D, D, N_IN1, false}, 32 * (N_IN1 / 32), tw, tn, lane3, scr); \
                    p0_convert(P0Mat{ffn_w_down, Wdn, nullptr, FF, D, false}, J5, tw, tn, lane3, scr); } \
                } \
            } else {     \
                { pg8::SubOrder S; S.init(T, FF2, G_, bx); S.lo = NT_MAIN; S.hi = NT_ALL; \
                  pg8::gemm_phase<pg8::EpiGLU, pg8::SubOrder, true, true>(lds, g, S, E); } \
                if (bx >= tail0) { \
                    { int tid3 = threadIdx.x; asm volatile("" : "+v"(tid3)); const int lane3 = tid3 & 63, wave3 = __builtin_amdgcn_readfirstlane(tid3 >> 6); \
                    const int tw = (bx - tail0) * 8 + wave3, tn = (G_ - tail0) * 8; LAS float* scr = (LAS float*)(lds + wave3 * 16384); \
                    p0_convert(P0Mat{wu1, wu1t, norm_ffn_g + D, D, FE, true, FF2, 0}, 32 * (FE / 32), tw, tn, lane3, scr); \
                    p0_convert(P0Mat{wu1, wu1t, norm_ffn_g + D, D, FE, true, FF2, FF}, 32 * (FE / 32), tw, tn, lane3, scr); \
                    p0_convert(P0Mat{ffn_w_down + (size_t)FF * D, Wdn + (size_t)D * FF, nullptr, FF, D, false}, J5, tw, tn, lane3, scr); } \
                } \
                GSYNC(); \
                { pg8::SubOrder S; S.init(T, FF2, G_, bx); S.lo = 0; S.hi = NT_MAIN; \
                  pg8::gemm_phase<pg8::EpiGLU, pg8::SubOrder, true, true>(lds, g, S, E); } \
            } \
        } \
        GSYNC(); \
        if (PH(9)) { \
            pg8::Gemm g{Z, Wdn + (size_t)layer * D * FF, T, D, FF}; pg8::StaticOrder S; S.init(T, D, G_, bx); \
            { pg8::Unit u0; S.next(0, u0); glu_fixup(EDGE, ffn_conv_w + (size_t)layer * 3 * FF, ffn_conv_b + (size_t)layer * FF, Z, u0.pm); } \
            if (layer == 0) { pg8::EpiRes<false, true> E{nullptr, D, HN, SS + (size_t)2 * T * 32}; pg8::gemm_phase<pg8::EpiRes<false, true>, pg8::StaticOrder, true, true>(lds, g, S, E); } \
            else { pg8::EpiRes<false, false> E{nullptr, D, HN, nullptr}; pg8::gemm_phase<pg8::EpiRes<false, false>, pg8::StaticOrder, true, true>(lds, g, S, E); } \
        } \
        GSYNC(); \
     \
    } while (0)
    RUN_LAYER(0);
    RUN_LAYER(1);
    { int tid2 = threadIdx.x; asm volatile("" : "+v"(tid2));
      const int lane2 = tid2 & 63, gw2 = vcu * 8 + (tid2 >> 6);
      rms_rows_final(HN, final_g, a.out, gw2, NGW, lane2); }
}

extern "C" void kernel_launch(void* const* d_in, const int* in_sizes, int n_in, void* d_out, int out_size, void* d_ws, size_t ws_size, hipStream_t stream) {
    static int grid = 0;
    if (grid == 0) {
        if (n_in != 16 || out_size != T * D || ws_size < WS_END2) { fprintf(stderr, "kernel_launch: unexpected problem (n_in %d, out %d, ws %zu)\n", n_in, out_size, ws_size); grid = -1; return; }
        int dev = 0, cus = 0, per_cu = 0;
        hipGetDevice(&dev); hipDeviceGetAttribute(&cus, hipDeviceAttributeMultiprocessorCount, dev);
        if (hipFuncSetAttribute((const void*)fwd_megakernel, hipFuncAttributeMaxDynamicSharedMemorySize, LDS_BYTES) != hipSuccess) { fprintf(stderr, "kernel_launch: hipFuncSetAttribute failed\n"); grid = -1; return; }
        if (hipOccupancyMaxActiveBlocksPerMultiprocessor(&per_cu, (const void*)fwd_megakernel, 512, LDS_BYTES) != hipSuccess || per_cu < 1) { fprintf(stderr, "kernel_launch: occupancy query failed (%d)\n", per_cu); (void)hipGetLastError(); per_cu = 1; }
        grid = cus * per_cu;
    }
    if (grid < 0) return;
    if (hipMemsetAsync(d_ws, 0, 16384, stream) != hipSuccess) { fprintf(stderr, "kernel_launch: memset failed\n"); return; }
    Args a{};
    for (int i = 0; i < 16; ++i) a.in[i] = (const float*)d_in[i];
    a.out = (float*)d_out; a.ws = (unsigned char*)d_ws;
    void* args[] = {&a};
    hipError_t e = hipLaunchCooperativeKernel((const void*)fwd_megakernel, dim3(grid), dim3(512), args, LDS_BYTES, stream);
    if (e != hipSuccess) fprintf(stderr, "kernel_launch: cooperative launch failed: %s (grid %d)\n", hipGetErrorString(e), grid);
}
```

```cpp
#include <hip/hip_runtime.h>
#include <hip/hip_cooperative_groups.h>
#include <cstdio>
#include <cstdint>
namespace cg = cooperative_groups;
namespace pg8 {
#define PG8_LAS __attribute__((address_space(3)))
typedef unsigned short bf16_t;
typedef short bf16x8 __attribute__((ext_vector_type(8)));
typedef float f32x4 __attribute__((ext_vector_type(4)));
typedef unsigned u32x4 __attribute__((ext_vector_type(4)));
constexpr int BM = 256, BK = 64, HALF = 128, HTB = HALF * BK * 2  , STAGE_BYTES = 8 * HTB, NXCD = 8, WGM = 4;

__host__ __device__ __forceinline__ int lds_byte(int r, int c) { const int st = (r >> 4) * 2 + (c >> 5), rr = r & 15, cc = c & 31, ob = rr * 64 + cc * 2; return st * 1024 + (ob ^ (((ob >> 9) & 1) << 5)); }
__host__ __device__ __forceinline__ void stage_rc(int b, int& R, int& C) { const int st = b / 1024, sb = b % 1024, swz = sb ^ (((sb >> 9) & 1) << 5); R = (st >> 1) * 16 + swz / 64; C = (st & 1) * 32 + (swz % 64) / 2; }
__host__ __device__ __forceinline__ int perm32(int rho) { const int n = rho >> 4, i = rho & 15; return 8 * (i >> 2) + 4 * n + (i & 3); }

struct Unit { int pm, pn; };
struct Gemm { const bf16_t* A; const bf16_t* Bt; int M, N, K; };

struct StaticOrder {
    int nM, nN, nwg, G, c;
    __host__ __device__ void init(int M, int N, int G_, int c_) { nM = M / BM; nN = N / BM; nwg = nM * nN; G = G_; c = c_; }
    __host__ __device__ bool next(int i, Unit& u) const {
        const long L = (long)i * G + c; if (L >= nwg) return false;
        int wgid = (int)L; { const int q = nwg / NXCD, r = nwg % NXCD, xcd = wgid % NXCD, off = wgid / NXCD; wgid = (xcd < r ? xcd * (q + 1) : r * (q + 1) + (xcd - r) * q) + off; }
        const int nig = WGM * nN, gid = wgid / nig, fm = gid * WGM, gsz = (nM - fm) < WGM ? (nM - fm) : WGM;
        u.pm = fm + ((wgid % nig) % gsz); u.pn = (wgid % nig) / gsz; return true;
    }
    __device__ __forceinline__ void a_ready(const Unit&) const {}
    __device__ __forceinline__ void done(const Unit&) const {}
};

typedef __bf16 bf16x2v __attribute__((ext_vector_type(2)));
typedef float f32x2v_ __attribute__((ext_vector_type(2)));
__device__ __forceinline__ unsigned cvt_pk_bf16(float lo, float hi) { f32x2v_ f = {lo, hi}; bf16x2v v = __builtin_convertvector(f, bf16x2v); return __builtin_bit_cast(unsigned, v); }
typedef float f32x2 __attribute__((ext_vector_type(2)));
__device__ __forceinline__ f32x2 gelu_pk(f32x2 v) {
    const f32x2 av = __builtin_elementwise_abs(v), d = av * 0.2316418882f + 1.0f;
    f32x2 t; t.x = __builtin_amdgcn_rcpf(d.x); t.y = __builtin_amdgcn_rcpf(d.y);
    f32x2 q = t * 0.5307027145f + (-0.7265760135f); q = q * t + 0.7107068705f; q = q * t + (-0.142248368f); q = q * t + 0.127414796f; q = q * t;
    const f32x2 s = (v * v) * (-0.72134752044f);
    f32x2 e; e.x = __builtin_amdgcn_exp2f(s.x); e.y = __builtin_amdgcn_exp2f(s.y);
    const f32x2 m = v * (q * e), r = v - m;
    f32x2 o; o.x = v.x < 0.f ? m.x : r.x; o.y = v.y < 0.f ? m.y : r.y; return o;
}


struct SubOrder : StaticOrder {
    int lo, hi;
    __host__ __device__ bool next(int i, Unit& u) const {
        const long L = (long)lo + (long)i * G + c; if (L >= hi) return false;
        int wgid = (int)L; { const int q = nwg / NXCD, r = nwg % NXCD, xcd = wgid % NXCD, off = wgid / NXCD; wgid = (xcd < r ? xcd * (q + 1) : r * (q + 1) + (xcd - r) * q) + off; }
        const int nig = WGM * nN, gid = wgid / nig, fm = gid * WGM, gsz = (nM - fm) < WGM ? (nM - fm) : WGM;
        u.pm = fm + ((wgid % nig) % gsz); u.pn = (wgid % nig) / gsz; return true;
    }
};

template <int MODE> struct EpiX {
    static constexpr bool PERM = true, AFTER_DRAIN = false;
    bf16_t* O; int ldc; float* G; const float* aux; const float* ss;
    __device__ __forceinline__ void operator()(const f32x4 (&acc)[2][2][4][2], const Unit& u, int wr, int wc, int fr, int fq) const {
        const int row0 = u.pm * BM + wr * 64 + fr; const int colt = u.pn * BM;
        const float sc = (MODE == 1 && colt < 1024) ? 0.08838834764831845f : 1.0f;
        const int col0 = colt + wc * 32 + 8 * fq;
        const bool lfmode = (MODE == 2) && (colt >= 6144);
        float lb[2][8];
        if (MODE == 2) {
#pragma unroll
            for (int bj = 0; bj < 2; ++bj) {
                if (lfmode) { const int ci = (col0 + bj * HALF - 6144) & 2047;
                    const f32x4 l00 = *(const f32x4*)(aux + ci), l01 = *(const f32x4*)(aux + ci + 4), l10 = *(const f32x4*)(aux + 2048 + ci), l11 = *(const f32x4*)(aux + 2048 + ci + 4);
#pragma unroll
                    for (int e = 0; e < 4; ++e) { lb[bj][e] = __builtin_amdgcn_rcpf(1.0f + __expf(l00[e] - l10[e])); lb[bj][4 + e] = __builtin_amdgcn_rcpf(1.0f + __expf(l01[e] - l11[e])); } }
                else {
#pragma unroll
                    for (int e = 0; e < 8; ++e) lb[bj][e] = 0.f; } }
        }
#pragma unroll
        for (int ai = 0; ai < 2; ++ai) {
            f32x4 t4[4];
#pragma unroll
            for (int m = 0; m < 4; ++m) { const f32x4* sp = (const f32x4*)(ss + (size_t)(row0 + ai * HALF + m * 16) * 32) + 2 * fq;
                t4[m] = sp[0] + sp[1]; }
            float rs[4];
#pragma unroll
            for (int m = 0; m < 4; ++m) { float tq = (t4[m][0] + t4[m][1]) + (t4[m][2] + t4[m][3]); tq += __shfl_xor(tq, 16); tq += __shfl_xor(tq, 32);
                rs[m] = rsqrtf(tq * (1.0f / 2048.0f) + 1e-6f) * sc; }
#pragma unroll
            for (int bj = 0; bj < 2; ++bj)
#pragma unroll
                for (int m = 0; m < 4; ++m) { bf16_t* rowp = O + (size_t)(row0 + ai * HALF + m * 16) * ldc + col0 + bj * HALF;
                    f32x4 v0 = acc[ai][bj][m][0] * rs[m], v1 = acc[ai][bj][m][1] * rs[m];
                    if (MODE == 2) { if (lfmode) {
#pragma unroll
                        for (int e = 0; e < 4; ++e) { const float s0 = __builtin_amdgcn_rcpf(1.0f + __expf(-v0[e])), s1 = __builtin_amdgcn_rcpf(1.0f + __expf(-v1[e]));
                            v0[e] = __builtin_amdgcn_logf(lb[bj][e] + (1.0f - lb[bj][e]) * s0); v1[e] = __builtin_amdgcn_logf(lb[bj][4 + e] + (1.0f - lb[bj][4 + e]) * s1);   } } }
                    u32x4 w; w.x = cvt_pk_bf16(v0[0], v0[1]); w.y = cvt_pk_bf16(v0[2], v0[3]); w.z = cvt_pk_bf16(v1[0], v1[1]); w.w = cvt_pk_bf16(v1[2], v1[3]);
                    *(u32x4*)rowp = w; }
        }
    }
};
template <bool RESF32, bool WITH_SS> struct EpiRes {
    static constexpr bool PERM = true, AFTER_DRAIN = false;
    const float* resf; int ldc; bf16_t* hn; float* ss;
    __device__ __forceinline__ void operator()(const f32x4 (&acc)[2][2][4][2], const Unit& u, int wr, int wc, int fr, int fq) const {
        const int row0 = u.pm * BM + wr * 64 + fr, col0 = u.pn * BM + wc * 32 + 8 * fq;
#pragma unroll
        for (int ai = 0; ai < 2; ++ai) {
            f32x4 r0[4][2], r1[4][2];
            if (RESF32) {
#pragma unroll
                for (int m = 0; m < 4; ++m)
#pragma unroll
                    for (int bj = 0; bj < 2; ++bj) { const size_t off = (size_t)(row0 + ai * HALF + m * 16) * ldc + col0 + bj * HALF; r0[m][bj] = *(const f32x4*)(resf + off); r1[m][bj] = *(const f32x4*)(resf + off + 4); }
            } else {
                u32x4 rw[4][2];
#pragma unroll
                for (int m = 0; m < 4; ++m)
#pragma unroll
                    for (int bj = 0; bj < 2; ++bj) rw[m][bj] = *(const u32x4*)(hn + (size_t)(row0 + ai * HALF + m * 16) * ldc + col0 + bj * HALF);
#pragma unroll
                for (int m = 0; m < 4; ++m)
#pragma unroll
                    for (int bj = 0; bj < 2; ++bj) { const u32x4 w = rw[m][bj];
                        r0[m][bj] = (f32x4){__builtin_bit_cast(float, w.x << 16), __builtin_bit_cast(float, w.x & 0xffff0000u), __builtin_bit_cast(float, w.y << 16), __builtin_bit_cast(float, w.y & 0xffff0000u)};
                        r1[m][bj] = (f32x4){__builtin_bit_cast(float, w.z << 16), __builtin_bit_cast(float, w.z & 0xffff0000u), __builtin_bit_cast(float, w.w << 16), __builtin_bit_cast(float, w.w & 0xffff0000u)}; }
            }
#pragma unroll
            for (int m = 0; m < 4; ++m) { const int row = row0 + ai * HALF + m * 16; const size_t off = (size_t)row * ldc + col0; float q = 0.f;
#pragma unroll
                for (int bj = 0; bj < 2; ++bj) {
                    const f32x4 o0 = r0[m][bj] + acc[ai][bj][m][0], o1 = r1[m][bj] + acc[ai][bj][m][1];
                    u32x4 w; w.x = cvt_pk_bf16(o0[0], o0[1]); w.y = cvt_pk_bf16(o0[2], o0[3]); w.z = cvt_pk_bf16(o1[0], o1[1]); w.w = cvt_pk_bf16(o1[2], o1[3]);
                    *(u32x4*)(hn + off + bj * HALF) = w;
                    if (WITH_SS) q += (o0[0] * o0[0] + o0[1] * o0[1]) + (o0[2] * o0[2] + o0[3] * o0[3]) + (o1[0] * o1[0] + o1[1] * o1[1]) + (o1[2] * o1[2] + o1[3] * o1[3]); }
                if (WITH_SS) { q += __shfl_xor(q, 16); q += __shfl_xor(q, 32); if (fq == 0) ss[(size_t)row * 32 + u.pn * 4 + wc] = q; } }
        }
    }
};


__device__ __forceinline__ float dpp_ror1(float x) { return __builtin_bit_cast(float, __builtin_amdgcn_update_dpp(0, __builtin_bit_cast(int, x), 0x121, 0xf, 0xf, false)); }
__device__ __forceinline__ float dpp_ror15(float x) { return __builtin_bit_cast(float, __builtin_amdgcn_update_dpp(0, __builtin_bit_cast(int, x), 0x12f, 0xf, 0xf, false)); }
struct EpiGLU {
    static constexpr bool PERM = true, AFTER_DRAIN = false;
    bf16_t* Z; float* EDGE; const float* cw; const float* cb; const float* ss; PG8_LAS float* ebuf;
    __device__ __forceinline__ void operator()(const f32x4 (&acc)[2][2][4][2], const Unit& u, int wr, int wc, int fr, int fq) const {
        constexpr int FFc = 5504;
        const int row0 = u.pm * BM + wr * 64 + fr;
        const int lcol = wc * 32 + 8 * fq;
        const int fcol = u.pn * 128 + lcol;
        float rs[2][4];
#pragma unroll
        for (int ai = 0; ai < 2; ++ai) {
            f32x4 t4[4];
#pragma unroll
            for (int m = 0; m < 4; ++m) { const f32x4* sp = (const f32x4*)(ss + (size_t)(row0 + ai * HALF + m * 16) * 32) + 2 * fq; t4[m] = sp[0] + sp[1]; }
#pragma unroll
            for (int m = 0; m < 4; ++m) { float tq = (t4[m][0] + t4[m][1]) + (t4[m][2] + t4[m][3]); tq += __shfl_xor(tq, 16); tq += __shfl_xor(tq, 32); rs[ai][m] = rsqrtf(tq * (1.0f / 2048.0f) + 1e-6f); }
        }
        {
            const f32x4 f00 = acc[0][0][0][0] * rs[0][0], f01 = acc[0][0][0][1] * rs[0][0], l00 = acc[0][0][3][0] * rs[0][3], l01 = acc[0][0][3][1] * rs[0][3];
            const f32x4 f10 = acc[1][0][0][0] * rs[1][0], f11 = acc[1][0][0][1] * rs[1][0], l10 = acc[1][0][3][0] * rs[1][3], l11 = acc[1][0][3][1] * rs[1][3];
            PG8_LAS float* e0 = ebuf + (wr * 2) * 128 + lcol;
            if (fr == 0) { *(PG8_LAS f32x4*)(e0) = f00; *(PG8_LAS f32x4*)(e0 + 4) = f01; *(PG8_LAS f32x4*)(e0 + 512) = f10; *(PG8_LAS f32x4*)(e0 + 516) = f11; }
            if (fr == 15) { *(PG8_LAS f32x4*)(e0 + 128) = l00; *(PG8_LAS f32x4*)(e0 + 132) = l01; *(PG8_LAS f32x4*)(e0 + 640) = l10; *(PG8_LAS f32x4*)(e0 + 644) = l11; }
            if (wr == 0 && fr < 2) { float* e = EDGE + ((size_t)u.pm * 6 + fr) * FFc + fcol;
                *(f32x4*)(e) = f00; *(f32x4*)(e + 4) = f01;
                if (fr == 0) { float* ev = EDGE + ((size_t)u.pm * 6 + 4) * FFc + fcol; *(f32x4*)(ev) = acc[0][1][0][0] * rs[0][0]; *(f32x4*)(ev + 4) = acc[0][1][0][1] * rs[0][0]; } }
            if (wr == 1 && fr >= 14) { float* e = EDGE + ((size_t)u.pm * 6 + 2 + (fr - 14)) * FFc + fcol;
                *(f32x4*)(e) = l10; *(f32x4*)(e + 4) = l11;
                if (fr == 15) { float* ev = EDGE + ((size_t)u.pm * 6 + 5) * FFc + fcol; *(f32x4*)(ev) = acc[1][1][3][0] * rs[1][3]; *(f32x4*)(ev + 4) = acc[1][1][3][1] * rs[1][3]; } }
        }
        asm volatile("s_waitcnt lgkmcnt(0)" ::: "memory"); __builtin_amdgcn_s_barrier(); asm volatile("" ::: "memory");
#pragma unroll
        for (int n = 0; n < 2; ++n) {
            const f32x4 w0 = *(const f32x4*)(cw + fcol + 4 * n), w1 = *(const f32x4*)(cw + FFc + fcol + 4 * n), w2 = *(const f32x4*)(cw + 2 * FFc + fcol + 4 * n), bb = *(const f32x4*)(cb + fcol + 4 * n);
#pragma unroll
            for (int ai = 0; ai < 2; ++ai) { const int blk = ai * 2 + wr;
#pragma unroll
                for (int m = 0; m < 4; ++m) {
                    const f32x4 zero4 = (f32x4){0.f, 0.f, 0.f, 0.f};
                    const f32x4 Ac = acc[ai][0][m][n] * rs[ai][m];
                    f32x4 pvs, nxs;
                    if (m > 0) { const f32x4 Ap = acc[ai][0][m > 0 ? m - 1 : 0][n] * rs[ai][m > 0 ? m - 1 : 0];
#pragma unroll
                        for (int e = 0; e < 4; ++e) pvs[e] = dpp_ror1(Ap[e]); }
                    else pvs = (blk > 0) ? *(const PG8_LAS f32x4*)(ebuf + ((blk - 1) * 2 + 1) * 128 + lcol + 4 * n) : zero4;
                    if (m < 3) { const f32x4 An = acc[ai][0][m < 3 ? m + 1 : 3][n] * rs[ai][m < 3 ? m + 1 : 3];
#pragma unroll
                        for (int e = 0; e < 4; ++e) nxs[e] = dpp_ror15(An[e]); }
                    else nxs = (blk < 3) ? *(const PG8_LAS f32x4*)(ebuf + ((blk + 1) * 2 + 0) * 128 + lcol + 4 * n) : zero4;
                    f32x4 pv, nx;
#pragma unroll
                    for (int e = 0; e < 4; ++e) { const float r1 = dpp_ror1(Ac[e]), l1 = dpp_ror15(Ac[e]); pv[e] = (fr == 0) ? pvs[e] : r1; nx[e] = (fr == 15) ? nxs[e] : l1; }
                    const f32x4 c = bb + w0 * pv + w1 * Ac + w2 * nx;
                    const f32x4 vv = acc[ai][1][m][n] * rs[ai][m];
                    const f32x2 g0 = gelu_pk((f32x2){c[0], c[1]}), g1 = gelu_pk((f32x2){c[2], c[3]});
                    typedef unsigned u32x2e __attribute__((ext_vector_type(2)));
                    u32x2e w; w.x = cvt_pk_bf16(g0.x * vv[0], g0.y * vv[1]); w.y = cvt_pk_bf16(g1.x * vv[2], g1.y * vv[3]);
                    *(u32x2e*)(Z + (size_t)(row0 + ai * HALF + m * 16) * FFc + fcol + 4 * n) = w;
                    __builtin_amdgcn_sched_barrier(0);
                }
            }
        }
    }
};

template <class Epi, class Sched, bool ALIGN_EPI = false, bool SP2 = false>
__device__ __forceinline__ void gemm_phase(PG8_LAS unsigned char* lds, const Gemm g, const Sched& S, const Epi& E) {
    int tid_ = threadIdx.x; asm volatile("" : "+v"(tid_));
    const int tid = tid_, wid = __builtin_amdgcn_readfirstlane(tid >> 6), lane = tid & 63, wr = wid >> 2, wc = wid & 3, fr = lane & 15, fq = lane >> 4;
    const int K = g.K, nt = K / BK;
    unsigned voffA[2], voffB[2];
#pragma unroll
    for (int i = 0; i < 2; ++i) { int R, C; stage_rc(tid * 16 + i * 8192, R, C); const int Rb = Epi::PERM ? ((R & ~31) + perm32(R & 31)) : R;
        voffA[i] = (unsigned)(R * K + C) * 2u; voffB[i] = (unsigned)(Rb * K + C) * 2u; }
    const size_t kstep = (size_t)(BK * 2);
    const size_t hstep = (size_t)HALF * K * 2;
    const size_t tstep = 2 * hstep;
    const unsigned ldsw = (unsigned)wid * 1024u;
    const int aoff = lds_byte(wr * 64 + fr, fq * 8), boff = lds_byte(wc * 32 + fr, fq * 8);
#define PG8_SA(b, h) (((b) * 2 + (h)) * HTB)
#define PG8_SB(b, h) ((4 + (b) * 2 + (h)) * HTB)
#define PG8_STAGE(bufoff, gbase, voff) do { _Pragma("unroll") for (int _i = 0; _i < 2; ++_i) \
        __builtin_amdgcn_global_load_lds((const unsigned*)((const char*)(gbase) + (voff)[_i]), (PG8_LAS unsigned*)(lds + (bufoff) + ldsw + _i * 8192), 16, 0, 0); } while (0)
#define PG8_LDA(dst, b, h) do { _Pragma("unroll") for (int m = 0; m < 4; ++m) _Pragma("unroll") for (int k = 0; k < 2; ++k) dst[m][k] = *(const PG8_LAS bf16x8*)(lds + PG8_SA(b, h) + aoff + m * 2048 + k * 1024); } while (0)
#define PG8_LDB(dst, b, h) do { _Pragma("unroll") for (int n = 0; n < 2; ++n) _Pragma("unroll") for (int k = 0; k < 2; ++k) dst[n][k] = *(const PG8_LAS bf16x8*)(lds + PG8_SB(b, h) + boff + n * 2048 + k * 1024); } while (0)
#define PG8_MMA(ai, bj, At, Bt) do { __builtin_amdgcn_s_setprio(1); _Pragma("unroll") for (int m = 0; m < 4; ++m) _Pragma("unroll") for (int n = 0; n < 2; ++n) _Pragma("unroll") for (int k = 0; k < 2; ++k) \
        acc[ai][bj][m][n] = __builtin_amdgcn_mfma_f32_16x16x32_bf16(Bt[n][k], At[m][k], acc[ai][bj][m][n], 0, 0, 0); __builtin_amdgcn_s_setprio(0); } while (0)
#define PG8_WAIT_V(n) asm volatile("s_waitcnt vmcnt(" #n ")" ::: "memory")
#define PG8_WAIT_L(n) asm volatile("s_waitcnt lgkmcnt(" #n ")" ::: "memory")
#define PG8_BAR __builtin_amdgcn_s_barrier()
#define PG8_SCHED __builtin_amdgcn_sched_barrier(0)
    Unit cur, nxt; int ui = 0;
    if (!S.next(0, cur)) return;
    f32x4 acc[2][2][4][2];
#pragma unroll
    for (int a = 0; a < 2; ++a)
#pragma unroll
        for (int b = 0; b < 2; ++b)
#pragma unroll
            for (int m = 0; m < 4; ++m)
#pragma unroll
                for (int n = 0; n < 2; ++n) acc[a][b][m][n] = (f32x4){0.f, 0.f, 0.f, 0.f};
    bf16x8 At[4][2], B0[2][2], B1[2][2];
    const char* cA = (const char*)g.A + (size_t)cur.pm * tstep; const char* cB = (const char*)g.Bt + (size_t)cur.pn * tstep;
    S.a_ready(cur);
    if constexpr (SP2) {
        PG8_STAGE(PG8_SB(0, 0), cB, voffB); PG8_STAGE(PG8_SB(0, 1), cB + hstep, voffB); PG8_STAGE(PG8_SA(0, 0), cA, voffA); PG8_STAGE(PG8_SA(0, 1), cA + hstep, voffA);
        if (wr == 1) PG8_BAR;
        PG8_WAIT_V(2); PG8_BAR;
        PG8_STAGE(PG8_SB(1, 0), cB + kstep, voffB); PG8_STAGE(PG8_SA(1, 0), cA + kstep, voffA); PG8_STAGE(PG8_SB(1, 1), cB + hstep + kstep, voffB);
        PG8_WAIT_V(6); PG8_BAR;
    } else {
        PG8_STAGE(PG8_SB(0, 0), cB, voffB); PG8_STAGE(PG8_SA(0, 0), cA, voffA); PG8_STAGE(PG8_SB(0, 1), cB + hstep, voffB); PG8_STAGE(PG8_SA(0, 1), cA + hstep, voffA);
        if (wr == 1) PG8_BAR;
        PG8_WAIT_V(4); PG8_BAR;
        PG8_STAGE(PG8_SB(1, 0), cB + kstep, voffB); PG8_STAGE(PG8_SA(1, 0), cA + kstep, voffA); PG8_STAGE(PG8_SB(1, 1), cB + hstep + kstep, voffB);
        PG8_WAIT_V(6); PG8_BAR;
    }
    for (;;) {
        const bool has_next = S.next(ui + 1, nxt);
        const char* nA = has_next ? (const char*)g.A + (size_t)nxt.pm * tstep : cA; const char* nB = has_next ? (const char*)g.Bt + (size_t)nxt.pn * tstep : cB;
        for (int t = 0; t < nt; t += 2) {
            const bool last = (t == nt - 2);
            const char* a1 = cA + (size_t)(t + 1) * kstep;
            const char* a2 = last ? nA : cA + (size_t)(t + 2) * kstep; const char* b2 = last ? nB : cB + (size_t)(t + 2) * kstep;
            const char* a3 = a2 + kstep; const char* b3 = b2 + kstep;
            if (last && has_next) S.a_ready(nxt);
            if constexpr (SP2) {
            PG8_LDB(B0, 0, 0); PG8_LDB(B1, 0, 1); PG8_SCHED; PG8_LDA(At, 0, 0); PG8_STAGE(PG8_SA(1, 1), a1 + hstep, voffA);
            PG8_WAIT_V(8); PG8_WAIT_L(0); PG8_BAR; PG8_MMA(0, 0, At, B0); PG8_MMA(0, 1, At, B1); PG8_BAR; PG8_SCHED;
            PG8_LDA(At, 0, 1); PG8_STAGE(PG8_SB(0, 0), b2, voffB); PG8_STAGE(PG8_SB(0, 1), b2 + hstep, voffB); PG8_STAGE(PG8_SA(0, 0), a2, voffA);
            PG8_WAIT_V(8); PG8_WAIT_L(0); PG8_BAR; PG8_MMA(1, 0, At, B0); PG8_MMA(1, 1, At, B1); PG8_BAR; PG8_SCHED;
            PG8_LDB(B0, 1, 0); PG8_LDB(B1, 1, 1); PG8_SCHED; PG8_LDA(At, 1, 0); PG8_STAGE(PG8_SA(0, 1), a2 + hstep, voffA);
            PG8_WAIT_V(8); PG8_WAIT_L(0); PG8_BAR; PG8_MMA(0, 0, At, B0); PG8_MMA(0, 1, At, B1); PG8_BAR; PG8_SCHED;
            PG8_LDA(At, 1, 1); PG8_STAGE(PG8_SB(1, 0), b3, voffB); PG8_STAGE(PG8_SB(1, 1), b3 + hstep, voffB); PG8_STAGE(PG8_SA(1, 0), a3, voffA);
            PG8_WAIT_V(8); PG8_WAIT_L(0); PG8_BAR; PG8_MMA(1, 0, At, B0); PG8_MMA(1, 1, At, B1); PG8_BAR; PG8_SCHED;
            } else {
            PG8_LDB(B0, 0, 0); PG8_SCHED; PG8_LDA(At, 0, 0); PG8_STAGE(PG8_SA(1, 1), a1 + hstep, voffA);
            PG8_WAIT_L(8); PG8_BAR; PG8_WAIT_L(0); PG8_MMA(0, 0, At, B0); PG8_BAR; PG8_SCHED;
            PG8_LDB(B1, 0, 1); PG8_STAGE(PG8_SB(0, 0), b2, voffB);
            PG8_BAR; PG8_WAIT_L(0); PG8_MMA(0, 1, At, B1); PG8_BAR;
            PG8_LDA(At, 0, 1); PG8_STAGE(PG8_SA(0, 0), a2, voffA);
            PG8_BAR; PG8_WAIT_L(0); PG8_MMA(1, 0, At, B0); PG8_BAR; PG8_SCHED;
            PG8_STAGE(PG8_SB(0, 1), b2 + hstep, voffB);
            PG8_WAIT_V(6); PG8_BAR; PG8_MMA(1, 1, At, B1); PG8_BAR;
            PG8_LDB(B0, 1, 0); PG8_SCHED; PG8_LDA(At, 1, 0); PG8_STAGE(PG8_SA(0, 1), a2 + hstep, voffA);
            PG8_WAIT_L(8); PG8_BAR; PG8_WAIT_L(0); PG8_MMA(0, 0, At, B0); PG8_BAR; PG8_SCHED;
            PG8_LDB(B1, 1, 1); PG8_STAGE(PG8_SB(1, 0), b3, voffB);
            PG8_BAR; PG8_WAIT_L(0); PG8_MMA(0, 1, At, B1); PG8_BAR;
            PG8_LDA(At, 1, 1); PG8_STAGE(PG8_SA(1, 0), a3, voffA);
            PG8_BAR; PG8_WAIT_L(0); PG8_MMA(1, 0, At, B0); PG8_BAR; PG8_SCHED;
            PG8_STAGE(PG8_SB(1, 1), b3 + hstep, voffB);
            PG8_WAIT_V(6); PG8_BAR; PG8_MMA(1, 1, At, B1); PG8_BAR;
            }
        }
        if constexpr (ALIGN_EPI) { if (wr == 0) PG8_BAR; }
        if constexpr (!Epi::AFTER_DRAIN) { E(acc, cur, wr, wc, fr, fq); S.done(cur); }
        if (!has_next) break;
#pragma unroll
        for (int a = 0; a < 2; ++a)
#pragma unroll
            for (int b = 0; b < 2; ++b)
#pragma unroll
                for (int m = 0; m < 4; ++m)
#pragma unroll
                    for (int n = 0; n < 2; ++n) acc[a][b][m][n] = (f32x4){0.f, 0.f, 0.f, 0.f};
        cur = nxt; cA = nA; cB = nB; ++ui;
        if constexpr (ALIGN_EPI) { if (wr == 1) PG8_BAR; }
    }
    PG8_WAIT_V(0);
    if constexpr (!ALIGN_EPI) { if (wr == 0) PG8_BAR; }
    PG8_BAR;
    if constexpr (Epi::AFTER_DRAIN) { E.fused(acc, cur, wr, wc, fr, fq, lds, wid, lane); S.done(cur); }
#undef PG8_SA
#undef PG8_SB
#undef PG8_STAGE
#undef PG8_LDA
#undef PG8_LDB
#undef PG8_MMA
#undef PG8_WAIT_V
#undef PG8_WAIT_L
#undef PG8_BAR
#undef PG8_SCHED
}
}

constexpr int T = 8192, D = 2048, SEQ = 2048;
constexpr int N_IN0 = 6176, N_IN0P = 6400, LDP0 = 6144;
constexpr int N_IN1 = 10240;
constexpr int FF = 5504, FF2 = 11008;
constexpr float EPS = 1e-6f;
constexpr size_t MiB = 1u << 20;
constexpr size_t WS_WIN0 = 1 * MiB;
constexpr size_t WS_WOUT0 = WS_WIN0 + 25 * MiB;
constexpr size_t WS_WIN1 = WS_WOUT0 + 8 * MiB;
constexpr size_t WS_WOUT1 = WS_WIN1 + 40 * MiB;
constexpr size_t WS_WUP = WS_WOUT1 + 8 * MiB;
constexpr size_t WS_WDN = WS_WUP + 86 * MiB;
constexpr size_t WS_HN = WS_WDN + 43 * MiB;
constexpr size_t WS_H = WS_HN + 32 * MiB;
constexpr size_t WS_G0 = WS_H + 64 * MiB;
constexpr size_t WS_PU = WS_G0 + 1 * MiB;
constexpr size_t WS_YF = WS_PU + 172 * MiB;
constexpr size_t WS_YB = WS_YF + 32 * MiB;
constexpr size_t WS_Y = WS_YB + 32 * MiB;
constexpr size_t WS_Z = WS_Y + 32 * MiB;
constexpr size_t WS_END = WS_Z + 86 * MiB;
constexpr size_t WS_SS = WS_END;
constexpr size_t WS_EDGE = WS_END + 4 * MiB;
constexpr size_t WS_END2 = WS_EDGE + 5 * MiB;
constexpr int UP_TAIL = (32 * (FF2 / 256)) % 256;
constexpr int LDS_BYTES = 147456;

#define LAS __attribute__((address_space(3)))
typedef LAS unsigned char* ldsp;
typedef unsigned short bf16;
typedef float f32x4 __attribute__((ext_vector_type(4)));
typedef short bf16x8 __attribute__((ext_vector_type(8)));
typedef unsigned u32x4 __attribute__((ext_vector_type(4)));
typedef unsigned u32x2 __attribute__((ext_vector_type(2)));

__device__ __forceinline__ float bf2f(unsigned b) { return __builtin_bit_cast(float, b << 16); }
typedef __bf16 bf16x2_t __attribute__((ext_vector_type(2)));
typedef float f32x2_t __attribute__((ext_vector_type(2)));
__device__ __forceinline__ unsigned pk2(float lo, float hi) { f32x2_t f = {lo, hi}; bf16x2_t v = __builtin_convertvector(f, bf16x2_t); return __builtin_bit_cast(unsigned, v); }
__device__ __forceinline__ float wave_sum(float v) {
#pragma unroll
    for (int o = 1; o < 64; o <<= 1) v += __shfl_xor(v, o);
    return v;
}
#define LDS_WAIT() asm volatile("s_waitcnt lgkmcnt(0)" ::: "memory")

struct P0Mat { const float* W; bf16* WT; const float* gk; int K, N; bool glu; int ld = 0, noff = 0; };
__device__ __forceinline__ void p0_load(const P0Mat m, int item, int lane, float (&wv)[32]) {
    const int nblk = m.N / 32, kb = item / nblk, nb = item % nblk, k0 = 64 * kb, n0 = m.noff + 32 * nb, ld = m.ld ? m.ld : m.N;
    const float* wp = m.W + (size_t)(k0 + (lane >> 5)) * ld + n0 + (lane & 31);
#pragma unroll
    for (int i = 0; i < 32; ++i) wv[i] = __builtin_nontemporal_load(wp + (size_t)(2 * i) * ld);
}
__device__ __forceinline__ void p0_finish(const P0Mat m, int item, int lane, const float (&wv)[32], LAS float* scr) {
    const int nblk = m.N / 32, kb = item / nblk, nb = item % nblk, k0 = 64 * kb, n0 = m.noff + 32 * nb;
#pragma unroll
    for (int i = 0; i < 32; ++i) scr[(2 * i + (lane >> 5)) * 33 + (lane & 31)] = wv[i];
    LDS_WAIT(); asm volatile("" ::: "memory");
    const int c = lane & 7;
    float g8[8];
#pragma unroll
    for (int i = 0; i < 8; ++i) g8[i] = m.gk ? m.gk[k0 + 8 * c + i] : 1.0f;
#pragma unroll
    for (int j = 0; j < 4; ++j) { const int n = (lane >> 3) + 8 * j; const LAS float* s = scr + (8 * c) * 33 + n;
        u32x4 o; o.x = pk2(s[0 * 33] * g8[0], s[1 * 33] * g8[1]); o.y = pk2(s[2 * 33] * g8[2], s[3 * 33] * g8[3]); o.z = pk2(s[4 * 33] * g8[4], s[5 * 33] * g8[5]); o.w = pk2(s[6 * 33] * g8[6], s[7 * 33] * g8[7]);
        const int d0 = !m.glu ? n0 : (n0 < FF ? ((n0 >> 7) * 256 + (n0 & 127)) : ((((n0 - FF) >> 7) * 256) + 128 + ((n0 - FF) & 127)));
        *(u32x4*)(m.WT + (size_t)(d0 + n) * m.K + k0 + 8 * c) = o; }
    LDS_WAIT(); asm volatile("" ::: "memory");
}
__device__ __forceinline__ void p0_convert(const P0Mat m, int count, int first, int stride, int lane, LAS float* scr) {
    if (first >= count) return;
    float wa[32], wb[32];
    p0_load(m, first, lane, wa);
#pragma unroll 1
    for (int it = first; it < count; it += 2 * stride) {
        const bool h1 = it + stride < count, h2 = it + 2 * stride < count;
        if (h1) p0_load(m, it + stride, lane, wb);
        p0_finish(m, it, lane, wa, scr);
        if (h2) p0_load(m, it + 2 * stride, lane, wa);
        if (h1) p0_finish(m, it + stride, lane, wb, scr);
    }
}
__device__ __forceinline__ void p0_transpose_item(const float* W, int K, int N, bf16* WT, LAS float* scr, int item, int lane, const float* gk = nullptr, bool glu = false) {
    const P0Mat m{W, WT, gk, K, N, glu}; float wv[32]; p0_load(m, item, lane, wv); p0_finish(m, item, lane, wv, scr);
}

__device__ __forceinline__ void unpack8(const u32x4 w, float (&o)[8]) {
    o[0] = bf2f(w.x & 0xffffu); o[1] = bf2f(w.x >> 16); o[2] = bf2f(w.y & 0xffffu); o[3] = bf2f(w.y >> 16);
    o[4] = bf2f(w.z & 0xffffu); o[5] = bf2f(w.z >> 16); o[6] = bf2f(w.w & 0xffffu); o[7] = bf2f(w.w >> 16);
}
__device__ __forceinline__ void rms_rows_final(const bf16* src, const float* g, float* dstf, int gw, int NGW, int lane) {
    for (int row = gw; row < T; row += NGW) {
        const u32x4* xr = (const u32x4*)(src + (size_t)row * D) + lane;
        float v[4][8]; float ss = 0.f;
#pragma unroll
        for (int j = 0; j < 4; ++j) { unpack8(xr[64 * j], v[j]);
#pragma unroll
            for (int e = 0; e < 8; ++e) ss += v[j][e] * v[j][e]; }
        const float r = rsqrtf(wave_sum(ss) * (1.0f / D) + EPS);
#pragma unroll
        for (int j = 0; j < 4; ++j) { const int c = (lane + 64 * j) * 8; const f32x4 g0 = *(const f32x4*)(g + c), g1 = *(const f32x4*)(g + c + 4);
            f32x4 o0, o1;
#pragma unroll
            for (int e = 0; e < 4; ++e) { o0[e] = v[j][e] * r * g0[e]; o1[e] = v[j][4 + e] * r * g1[e]; }
            *(f32x4*)(dstf + (size_t)row * D + c) = o0; *(f32x4*)(dstf + (size_t)row * D + c + 4) = o1; }
    }
}
__device__ __forceinline__ void cast_rows(const float* src, bf16* dstb, float* ss, int gw, int NGW, int lane) {
    for (int row = gw; row < T; row += NGW) {
        const f32x4* xr = (const f32x4*)(src + (size_t)row * D) + lane;
        f32x4 v[8]; float q = 0.f;
#pragma unroll
        for (int j = 0; j < 8; ++j) { v[j] = xr[64 * j]; q += (v[j].x * v[j].x + v[j].y * v[j].y) + (v[j].z * v[j].z + v[j].w * v[j].w); }
        q = wave_sum(q);
#pragma unroll
        for (int j = 0; j < 8; ++j) { u32x2 w; w.x = pk2(v[j].x, v[j].y); w.y = pk2(v[j].z, v[j].w); ((u32x2*)(dstb + (size_t)row * D))[lane + 64 * j] = w; }
        if (lane < 32) ss[(size_t)row * 32 + lane] = (lane == 0) ? q : 0.f;
    }
}

template <int HD, bool SILU>
__device__ __forceinline__ void gatenorm(const bf16* __restrict__ YF, const bf16* __restrict__ YB, const bf16* __restrict__ gate, int ldg, const float* __restrict__ hg, bf16* __restrict__ Y, int gw, int NGW, int lane) {
    constexpr int NB = 4;
    for (int it0 = gw * NB; it0 < T * 8; it0 += NGW * NB) {
        u32x2 a[NB], b[NB], gq[NB]; f32x4 hgv[NB];
#pragma unroll
        for (int k = 0; k < NB; ++k) { const int item = it0 + k, tok = item >> 3, col = (item & 7) * 256 + lane * 4;
            a[k] = *(const u32x2*)(YF + (size_t)tok * D + col); b[k] = *(const u32x2*)(YB + (size_t)tok * D + col); gq[k] = *(const u32x2*)(gate + (size_t)tok * ldg + col); hgv[k] = *(const f32x4*)(hg + col); }
#pragma unroll
        for (int k = 0; k < NB; ++k) { const int item = it0 + k, tok = item >> 3, col = (item & 7) * 256 + lane * 4;
            float y[4] = { bf2f(a[k].x & 0xffffu) + bf2f(b[k].x & 0xffffu), bf2f(a[k].x >> 16) + bf2f(b[k].x >> 16), bf2f(a[k].y & 0xffffu) + bf2f(b[k].y & 0xffffu), bf2f(a[k].y >> 16) + bf2f(b[k].y >> 16) };
            float gt[4] = { bf2f(gq[k].x & 0xffffu), bf2f(gq[k].x >> 16), bf2f(gq[k].y & 0xffffu), bf2f(gq[k].y >> 16) };
            float ss = (y[0] * y[0] + y[1] * y[1]) + (y[2] * y[2] + y[3] * y[3]);
#pragma unroll
            for (int o = 1; o < HD / 4; o <<= 1) ss += __shfl_xor(ss, o);
            const float r = rsqrtf(ss * (1.0f / HD) + EPS);
            float o4[4];
#pragma unroll
            for (int e = 0; e < 4; ++e) { const float sg = __builtin_amdgcn_rcpf(1.0f + __expf(-gt[e])); const float act = SILU ? gt[e] * sg : sg; o4[e] = y[e] * r * hgv[k][e] * act; }
            u32x2 w; w.x = pk2(o4[0], o4[1]); w.y = pk2(o4[2], o4[3]);
            *(u32x2*)(Y + (size_t)tok * D + col) = w; }
    }
}


__device__ __forceinline__ void glu_fixup(const float* __restrict__ EDGE, const float* __restrict__ cw, const float* __restrict__ cb, bf16* __restrict__ Z, int pm) {
    for (int v8 = threadIdx.x; v8 < 2 * (FF / 8); v8 += 512) {
        const int which = v8 / (FF / 8), c8 = (v8 % (FF / 8)) * 8;
        if (which == 0 ? ((pm & 7) == 0) : ((pm & 7) == 7)) continue;
        const float* pp = which == 0 ? EDGE + ((size_t)(pm - 1) * 6 + 3) * FF + c8 : EDGE + ((size_t)pm * 6 + 2) * FF + c8;
        const float* pc = which == 0 ? EDGE + ((size_t)pm * 6 + 0) * FF + c8 : EDGE + ((size_t)pm * 6 + 3) * FF + c8;
        const float* pn = which == 0 ? EDGE + ((size_t)pm * 6 + 1) * FF + c8 : EDGE + ((size_t)(pm + 1) * 6 + 0) * FF + c8;
        const float* pv = EDGE + ((size_t)pm * 6 + 4 + which) * FF + c8;
        float z[8];
#pragma unroll
        for (int h = 0; h < 2; ++h) { const f32x4 a0 = *(const f32x4*)(pp + 4 * h), a1 = *(const f32x4*)(pc + 4 * h), a2 = *(const f32x4*)(pn + 4 * h), vv = *(const f32x4*)(pv + 4 * h);
            const f32x4 k0 = *(const f32x4*)(cw + c8 + 4 * h), k1 = *(const f32x4*)(cw + FF + c8 + 4 * h), k2 = *(const f32x4*)(cw + 2 * FF + c8 + 4 * h), bb = *(const f32x4*)(cb + c8 + 4 * h);
            const f32x4 c = bb + k0 * a0 + k1 * a1 + k2 * a2;
            const pg8::f32x2 g0 = pg8::gelu_pk((pg8::f32x2){c[0], c[1]}), g1 = pg8::gelu_pk((pg8::f32x2){c[2], c[3]});
            z[4 * h] = g0.x * vv[0]; z[4 * h + 1] = g0.y * vv[1]; z[4 * h + 2] = g1.x * vv[2]; z[4 * h + 3] = g1.y * vv[3]; }
        u32x4 w; w.x = pk2(z[0], z[1]); w.y = pk2(z[2], z[3]); w.z = pk2(z[4], z[5]); w.w = pk2(z[6], z[7]);
        *(u32x4*)(Z + (size_t)(pm * 256 + (which ? 255 : 0)) * FF + c8) = w;
    }
    asm volatile("s_waitcnt vmcnt(0)" ::: "memory"); __syncthreads();
}

template <int KS> __device__ __forceinline__ void ld_frag(bf16x8 (&f)[KS], ldsp X, int xs, int r0, int fr, int fq) {
    ldsp p = X + (r0 + fr) * xs + fq * 16;
#pragma unroll
    for (int k = 0; k < KS; ++k) f[k] = *(const LAS bf16x8*)(p + k * 64);
}
template <int KS> __device__ __forceinline__ f32x4 mma_frag(const bf16x8 (&a)[KS], const bf16x8 (&b)[KS], f32x4 acc) {
#pragma unroll
    for (int k = 0; k < KS; ++k) acc = __builtin_amdgcn_mfma_f32_16x16x32_bf16(a[k], b[k], acc, 0, 0, 0);
    return acc;
}
constexpr int QS = 272, TS = 144;


__device__ __forceinline__ void gate_gemm(ldsp lds, const bf16* HN, const bf16* Wg, const float* ss, const float* bias, float* G, int blk, int nblk) {
    const int tid = threadIdx.x, lane = tid & 63, wid = __builtin_amdgcn_readfirstlane(tid >> 6), fr = lane & 15, fq = lane >> 4;
    LAS float* red = (LAS float*)lds;
    for (int rb = blk; rb < T / 32; rb += nblk) {
        const int R0 = rb * 32, k0 = wid * 256;
        f32x4 acc[2][2];
#pragma unroll
        for (int a = 0; a < 2; ++a)
#pragma unroll
            for (int b = 0; b < 2; ++b) acc[a][b] = (f32x4){0.f, 0.f, 0.f, 0.f};
        bf16x8 fa[2][8], fb[2][8];
#pragma unroll
        for (int t = 0; t < 2; ++t)
#pragma unroll
            for (int k = 0; k < 8; ++k) { fa[t][k] = *(const bf16x8*)(HN + (size_t)(R0 + t * 16 + fr) * D + k0 + k * 32 + fq * 8); fb[t][k] = *(const bf16x8*)(Wg + (size_t)(t * 16 + fr) * D + k0 + k * 32 + fq * 8); }
#pragma unroll
        for (int k = 0; k < 8; ++k)
#pragma unroll
            for (int a = 0; a < 2; ++a)
#pragma unroll
                for (int b = 0; b < 2; ++b) acc[a][b] = __builtin_amdgcn_mfma_f32_16x16x32_bf16(fa[a][k], fb[b][k], acc[a][b], 0, 0, 0);
        __syncthreads();
#pragma unroll
        for (int a = 0; a < 2; ++a)
#pragma unroll
            for (int b = 0; b < 2; ++b)
#pragma unroll
                for (int j = 0; j < 4; ++j) red[(wid * 32 + a * 16 + fq * 4 + j) * 33 + b * 16 + fr] = acc[a][b][j];
        __syncthreads();
#pragma unroll
        for (int e = 0; e < 2; ++e) { const int o = tid + 512 * e, row = o >> 5, col = o & 31; float v = 0.f;
#pragma unroll
            for (int w = 0; w < 8; ++w) v += red[(w * 32 + row) * 33 + col];
            const float rs = rsqrtf(ss[(size_t)(R0 + row) * 32] * (1.0f / 2048.0f) + 1e-6f);
            G[(size_t)(R0 + row) * 32 + col] = v * rs + bias[col]; }
    }
    __syncthreads();
}

__device__ __forceinline__ void mlstm_phase(ldsp lds, const bf16* P, const float* G, bf16* YF, bf16* YB, int vcu, int G_) {
    const int tid = threadIdx.x, lane = tid & 63, wid = __builtin_amdgcn_readfirstlane(tid >> 6), fr = lane & 15, fq = lane >> 4;
    ldsp sQ = lds, sK = sQ + 64 * QS, sKt = sK + 64 * QS, sVt = sKt + 128 * TS, sP = sVt + 80 * TS, sC = sP + 64 * TS;
    LAS float* sDen = (LAS float*)(sC + 80 * QS);
    LAS float* sPre = sDen + 64;
    LAS float* sCh = sPre + 32 * 192;
    LAS float* sMst = sCh + 64;
    for (int unit = vcu; unit < 256; unit += G_) {
        const int slice = unit & 3, dir = (unit >> 2) & 1, h = (unit >> 3) & 7, b = unit >> 6;
        bf16* Yo = dir ? YB : YF;
#define ML_TOK(ci, i) (b * SEQ + (dir ? (SEQ - 1 - ((ci) * 64 + (i))) : ((ci) * 64 + (i))))
        __syncthreads();
        for (int i = tid; i < 80 * QS / 4; i += 512) ((LAS unsigned*)sC)[i] = 0u;
        for (int i = tid; i < 16 * TS / 4; i += 512) ((LAS unsigned*)(sVt + 64 * TS))[i] = (i < TS / 4) ? 0x3f803f80u : 0u;
        {
            float gi[4], gf[4];
#pragma unroll
            for (int c = 0; c < 4; ++c) { const float* gp = G + (size_t)ML_TOK(wid * 4 + c, lane) * 32 + dir * 16 + h; gi[c] = gp[0]; gf[c] = gp[8]; }
#pragma unroll
            for (int c = 0; c < 4; ++c) {
                const float lf = (gf[c] >= 0.f) ? -log1pf(__expf(-gf[c])) : gf[c] - log1pf(__expf(gf[c]));
                float bc = lf;
#pragma unroll
                for (int o = 1; o < 64; o <<= 1) { const float t = __shfl_up(bc, o); if (lane >= o) bc += t; }
                const float u = gi[c] - bc; float pm = u;
#pragma unroll
                for (int o = 1; o < 64; o <<= 1) { const float t = __shfl_up(pm, o); if (lane >= o) pm = fmaxf(pm, t); }
                LAS float* pp = sPre + (wid * 4 + c) * 192;
                pp[lane] = bc; pp[64 + lane] = u; pp[128 + lane] = pm;
                if (lane == 63) { sCh[(wid * 4 + c) * 2] = bc; sCh[(wid * 4 + c) * 2 + 1] = pm; }
            }
        }
        __syncthreads();
        if (wid == 0) { float m = 0.f;
#pragma unroll 1
            for (int c = 0; c < 32; ++c) { if (lane == 0) sMst[c] = m; const float gt = sCh[2 * c], p63 = sCh[2 * c + 1]; m = gt + fmaxf(m, p63); } }
        f32x4 CT[5];
#pragma unroll
        for (int n = 0; n < 5; ++n) CT[n] = (f32x4){0.f, 0.f, 0.f, 0.f};
        u32x4 rq[2], rk[2]; unsigned rv[8];
#define ML_LOAD(ci) do { \
            _Pragma("unroll") for (int j = 0; j < 2; ++j) { const int id = tid + 512 * j, row = id >> 4, c16 = id & 15; const bf16* rp = P + (size_t)ML_TOK(ci, row) * LDP0 + h * 128 + c16 * 8; \
                rq[j] = *(const u32x4*)rp; rk[j] = *(const u32x4*)(rp + 1024); } \
            _Pragma("unroll") for (int e = 0; e < 8; ++e) rv[e] = P[(size_t)ML_TOK(ci, wid * 8 + e) * LDP0 + 2048 + h * 256 + slice * 64 + lane]; } while (0)
        ML_LOAD(0);
#pragma unroll 1
        for (int ci = 0; ci < 32; ++ci) {
            const LAS float* pp = sPre + ci * 192;
#pragma unroll
            for (int j = 0; j < 2; ++j) { const int id = tid + 512 * j, row = id >> 4, c16 = id & 15; *(LAS u32x4*)(sQ + row * QS + c16 * 16) = rq[j]; *(LAS u32x4*)(sK + row * QS + c16 * 16) = rk[j]; }
            { u32x4 w; w.x = rv[0] | (rv[1] << 16); w.y = rv[2] | (rv[3] << 16); w.z = rv[4] | (rv[5] << 16); w.w = rv[6] | (rv[7] << 16); *(LAS u32x4*)(sVt + lane * TS + wid * 16) = w; }
            if (ci + 1 < 32) ML_LOAD(ci + 1);
            __syncthreads();
            const float m_st = sMst[ci], mrel = fmaxf(m_st, sCh[2 * ci + 1]);
            const int w3 = wid & 3, mt0 = wid >> 2, mt1 = mt0 + 2;
            f32x4 acc[3];
            {
                bf16x8 fK[4], fa0[4], fa1[4];
                ld_frag<4>(fK, sK, QS, w3 * 16, fr, fq);
                ld_frag<4>(fa0, sQ, QS, mt0 * 16, fr, fq); ld_frag<4>(fa1, sQ, QS, mt1 * 16, fr, fq);
                const float cc = pp[64 + w3 * 16 + fr];
                const f32x4 pmA = *(const LAS f32x4*)(pp + 128 + mt0 * 16 + fq * 4), pmB = *(const LAS f32x4*)(pp + 128 + mt1 * 16 + fq * 4), pmC = *(const LAS f32x4*)(pp + 128 + w3 * 16 + fq * 4);
                const f32x4 u0 = *(const LAS f32x4*)(pp + 64 + wid * 8), u1 = *(const LAS f32x4*)(pp + 64 + wid * 8 + 4);
                unsigned kk[8];
#pragma unroll
                for (int e = 0; e < 8; ++e) kk[e] = *(const LAS unsigned*)(sK + (wid * 8 + e) * QS + lane * 4);
                const f32x4 z4 = (f32x4){0.f, 0.f, 0.f, 0.f};
                f32x4 s0 = z4, s1 = z4;
                if (w3 <= mt0) s0 = mma_frag<4>(fa0, fK, s0);
                s1 = mma_frag<4>(fa1, fK, s1);
                { bf16x8 fQ[4], fb0[4], fb1[4];
                  ld_frag<4>(fQ, sQ, QS, w3 * 16, fr, fq); ld_frag<4>(fb0, sC, QS, mt0 * 16, fr, fq); ld_frag<4>(fb1, sC, QS, mt1 * 16, fr, fq);
                  acc[0] = mma_frag<4>(fQ, fb0, z4); acc[1] = mma_frag<4>(fQ, fb1, z4); acc[2] = z4;
                  if (wid < 4) { bf16x8 fb2[4]; ld_frag<4>(fb2, sC, QS, 64, fr, fq); acc[2] = mma_frag<4>(fQ, fb2, z4); } }
                const int scol = w3 * 16 + fr;
#pragma unroll
                for (int j = 0; j < 4; ++j) { const int t0 = mt0 * 16 + fq * 4 + j, t1 = mt1 * 16 + fq * 4 + j;
                    const float e0 = (scol <= t0) ? s0[j] * __expf(cc - fmaxf(pmA[j], m_st)) : 0.f, e1 = (scol <= t1) ? s1[j] * __expf(cc - fmaxf(pmB[j], m_st)) : 0.f;
                    *(LAS unsigned short*)(sP + t0 * TS + scol * 2) = (unsigned short)(pk2(e0, 0.f) & 0xffffu); *(LAS unsigned short*)(sP + t1 * TS + scol * 2) = (unsigned short)(pk2(e1, 0.f) & 0xffffu); }
                f32x4 wi;
#pragma unroll
                for (int j = 0; j < 4; ++j) wi[j] = __expf(m_st - fmaxf(pmC[j], m_st));
                acc[0] *= wi; acc[1] *= wi; acc[2] *= wi;
                unsigned lo[8], hi[8];
#pragma unroll
                for (int e = 0; e < 8; ++e) { const float w = __expf((e < 4 ? u0[e & 3] : u1[e & 3]) - mrel); lo[e] = pk2(bf2f(kk[e] & 0xffffu) * w, 0.f) & 0xffffu; hi[e] = pk2(bf2f(kk[e] >> 16) * w, 0.f) & 0xffffu; }
                u32x4 a, c; a.x = lo[0] | (lo[1] << 16); a.y = lo[2] | (lo[3] << 16); a.z = lo[4] | (lo[5] << 16); a.w = lo[6] | (lo[7] << 16);
                c.x = hi[0] | (hi[1] << 16); c.y = hi[2] | (hi[3] << 16); c.z = hi[4] | (hi[5] << 16); c.w = hi[6] | (hi[7] << 16);
                *(LAS u32x4*)(sKt + (2 * lane) * TS + wid * 16) = a; *(LAS u32x4*)(sKt + (2 * lane + 1) * TS + wid * 16) = c;
            }
            __syncthreads();
            {
                bf16x8 fP[2], fKt[2], fV[5][2];
                ld_frag<2>(fP, sP, TS, w3 * 16, fr, fq); ld_frag<2>(fKt, sKt, TS, wid * 16, fr, fq);
#pragma unroll
                for (int n = 0; n < 5; ++n) ld_frag<2>(fV[n], sVt, TS, n * 16, fr, fq);
                if (mt0 == 0) { acc[0] = mma_frag<2>(fP, fV[0], acc[0]); acc[1] = mma_frag<2>(fP, fV[2], acc[1]); }
                else { acc[0] = mma_frag<2>(fP, fV[1], acc[0]); acc[1] = mma_frag<2>(fP, fV[3], acc[1]); }
                if (wid < 4) acc[2] = mma_frag<2>(fP, fV[4], acc[2]);
                const float dec = __expf(m_st - mrel);
#pragma unroll
                for (int n = 0; n < 5; ++n) { CT[n] *= dec; CT[n] = mma_frag<2>(fKt, fV[n], CT[n]); }
                if (wid < 4 && fr == 0) *(LAS f32x4*)(sDen + wid * 16 + fq * 4) = acc[2];
#pragma unroll
                for (int n = 0; n < 5; ++n) { u32x2 w; w.x = pk2(CT[n][0], CT[n][1]); w.y = pk2(CT[n][2], CT[n][3]); *(LAS u32x2*)(sC + (n * 16 + fr) * QS + (wid * 16 + fq * 4) * 2) = w; }
            }
            __syncthreads();
            { const f32x4 pm4 = *(const LAS f32x4*)(pp + 128 + w3 * 16 + fq * 4), bc4 = *(const LAS f32x4*)(pp + w3 * 16 + fq * 4), dn4 = *(const LAS f32x4*)(sDen + w3 * 16 + fq * 4);
              bf16* yp = Yo + (size_t)ML_TOK(ci, w3 * 16 + fq * 4) * D + h * 256 + slice * 64 + mt0 * 16 + fr;
              const long ystep = dir ? -(long)D : (long)D;
#pragma unroll
              for (int j = 0; j < 4; ++j) { const float rdn = __builtin_amdgcn_rcpf(fmaxf(fabsf(dn4[j]), __expf(-(bc4[j] + fmaxf(pm4[j], m_st)))));
                  yp[j * ystep] = (bf16)(pk2(acc[0][j] * rdn, 0.f) & 0xffffu); yp[j * ystep + 32] = (bf16)(pk2(acc[1][j] * rdn, 0.f) & 0xffffu); } }
        }
#undef ML_LOAD
#undef ML_TOK
    }
}

__device__ __forceinline__ void hgrn_phase(ldsp lds, const bf16* P, bf16* YF, bf16* YB, int vcu, int G_) {
    const int tid = threadIdx.x, lane = tid & 63, wid = __builtin_amdgcn_readfirstlane(tid >> 6), fr = lane & 15, fq = lane >> 4;
    ldsp sQs = lds, sQm = sQs + 64 * QS, sKm = sQm + 64 * QS, sKet = sKm + 64 * QS, sVt = sKet + 128 * TS, sP = sVt + 64 * TS, sS = sP + 64 * TS;
    LAS float* sSeg = (LAS float*)(sS + 64 * QS);
    LAS float* sDec = sSeg + 8 * 128;
    for (int unit = vcu; unit < 256; unit += G_) {
        const int slice = unit & 1, dir = (unit >> 1) & 1, h = (unit >> 2) & 15, b = unit >> 6;
        bf16* Yo = dir ? YB : YF;
        __syncthreads();
        for (int i = tid; i < 64 * QS / 4; i += 512) ((LAS unsigned*)sS)[i] = 0u;
        f32x4 ST[4];
#pragma unroll
        for (int n = 0; n < 4; ++n) ST[n] = (f32x4){0.f, 0.f, 0.f, 0.f};
        unsigned rq[8], rl[8], rv[8];
#define HG_TOK(ci, i) (b * SEQ + (dir ? (SEQ - 1 - ((ci) * 64 + (i))) : ((ci) * 64 + (i))))
#define HG_LOAD(ci) do { \
            _Pragma("unroll") for (int e = 0; e < 8; ++e) { const bf16* rp = P + (size_t)HG_TOK(ci, wid * 8 + e) * N_IN1 + h * 128; \
                rq[e] = *(const unsigned*)(rp + 2 * lane); rl[e] = *(const unsigned*)(rp + 6144 + dir * 2048 + 2 * lane); rv[e] = rp[2048 + slice * 64 + lane]; } } while (0)
        HG_LOAD(0);
        const int w3 = wid & 3, mt0 = wid >> 2, mt1 = mt0 + 2;
#pragma unroll 1
        for (int ci = 0; ci < 32; ++ci) {
            float l0[8], l1[8], c0[8], c1[8]; unsigned qc[8];
            { float a0 = 0.f, a1 = 0.f;
#pragma unroll
              for (int e = 0; e < 8; ++e) { l0[e] = bf2f(rl[e] & 0xffffu); l1[e] = bf2f(rl[e] >> 16); a0 += l0[e]; a1 += l1[e]; c0[e] = a0; c1[e] = a1; qc[e] = rq[e]; }
              *(LAS f32x2_t*)(sSeg + wid * 128 + 2 * lane) = (f32x2_t){a0, a1}; }
            { u32x4 w; w.x = rv[0] | (rv[1] << 16); w.y = rv[2] | (rv[3] << 16); w.z = rv[4] | (rv[5] << 16); w.w = rv[6] | (rv[7] << 16); *(LAS u32x4*)(sVt + lane * TS + wid * 16) = w; }
            if (ci + 1 < 32) HG_LOAD(ci + 1);
            __syncthreads();
            { float off0 = 0.f, off1 = 0.f, mid0 = 0.f, mid1 = 0.f, end0 = 0.f, end1 = 0.f;
              f32x2_t sg[8];
#pragma unroll
              for (int s = 0; s < 8; ++s) sg[s] = *(const LAS f32x2_t*)(sSeg + s * 128 + 2 * lane);
#pragma unroll
              for (int s = 0; s < 8; ++s) { if (s < wid) { off0 += sg[s].x; off1 += sg[s].y; } if (s < 4) { mid0 += sg[s].x; mid1 += sg[s].y; } end0 += sg[s].x; end1 += sg[s].y; }
              if (wid == 0) *(LAS f32x2_t*)(sDec + 2 * lane) = (f32x2_t){__builtin_amdgcn_exp2f(end0), __builtin_amdgcn_exp2f(end1)};
              unsigned lo[8], hi[8];
              const float im0 = __builtin_amdgcn_exp2f(-mid0), im1 = __builtin_amdgcn_exp2f(-mid1), em0 = __builtin_amdgcn_exp2f(end0 - mid0), em1 = __builtin_amdgcn_exp2f(end1 - mid1);
#pragma unroll
              for (int e = 0; e < 8; ++e) { const int t = wid * 8 + e; const float b0 = c0[e] + off0, b1 = c1[e] + off1;
                  const float q0 = bf2f(qc[e] & 0xffffu), q1 = bf2f(qc[e] >> 16);
                  const float k0 = 1.0f - __builtin_amdgcn_exp2f(l0[e]), k1 = 1.0f - __builtin_amdgcn_exp2f(l1[e]);
                  const float qs0 = q0 * __builtin_amdgcn_exp2f(b0), qs1 = q1 * __builtin_amdgcn_exp2f(b1), km0 = k0 * __builtin_amdgcn_exp2f(mid0 - b0), km1 = k1 * __builtin_amdgcn_exp2f(mid1 - b1);
                  *(LAS unsigned*)(sQs + t * QS + lane * 4) = pk2(qs0, qs1);
                  *(LAS unsigned*)(sQm + t * QS + lane * 4) = pk2(qs0 * im0, qs1 * im1);
                  *(LAS unsigned*)(sKm + t * QS + lane * 4) = pk2(km0, km1);
                  lo[e] = pk2(km0 * em0, 0.f) & 0xffffu; hi[e] = pk2(km1 * em1, 0.f) & 0xffffu; }
              u32x4 a, c; a.x = lo[0] | (lo[1] << 16); a.y = lo[2] | (lo[3] << 16); a.z = lo[4] | (lo[5] << 16); a.w = lo[6] | (lo[7] << 16);
              c.x = hi[0] | (hi[1] << 16); c.y = hi[2] | (hi[3] << 16); c.z = hi[4] | (hi[5] << 16); c.w = hi[6] | (hi[7] << 16);
              *(LAS u32x4*)(sKet + (2 * lane) * TS + wid * 16) = a; *(LAS u32x4*)(sKet + (2 * lane + 1) * TS + wid * 16) = c; }
            __syncthreads();
            f32x4 acc[2];
            { const f32x4 z4 = (f32x4){0.f, 0.f, 0.f, 0.f};
              f32x4 s0 = z4, s1 = z4;
              { bf16x8 fK[4], fa0[4], fa1[4];
                ld_frag<4>(fK, sKm, QS, w3 * 16, fr, fq); ld_frag<4>(fa0, sQm, QS, mt0 * 16, fr, fq); ld_frag<4>(fa1, sQm, QS, mt1 * 16, fr, fq);
                if (w3 <= mt0) s0 = mma_frag<4>(fa0, fK, s0);
                s1 = mma_frag<4>(fa1, fK, s1); }
              { bf16x8 fQ[4], fb0[4], fb1[4];
                ld_frag<4>(fQ, sQs, QS, w3 * 16, fr, fq); ld_frag<4>(fb0, sS, QS, mt0 * 16, fr, fq); ld_frag<4>(fb1, sS, QS, mt1 * 16, fr, fq);
                acc[0] = mma_frag<4>(fQ, fb0, z4); acc[1] = mma_frag<4>(fQ, fb1, z4); }
              const int scol = w3 * 16 + fr;
#pragma unroll
              for (int j = 0; j < 4; ++j) { const int t0 = mt0 * 16 + fq * 4 + j, t1 = mt1 * 16 + fq * 4 + j;
                  *(LAS unsigned short*)(sP + t0 * TS + scol * 2) = (unsigned short)(pk2((scol <= t0) ? s0[j] : 0.f, 0.f) & 0xffffu);
                  *(LAS unsigned short*)(sP + t1 * TS + scol * 2) = (unsigned short)(pk2((scol <= t1) ? s1[j] : 0.f, 0.f) & 0xffffu); } }
            __syncthreads();
            { bf16x8 fP[2], fKt[2], fV[4][2];
              ld_frag<2>(fP, sP, TS, w3 * 16, fr, fq); ld_frag<2>(fKt, sKet, TS, wid * 16, fr, fq);
#pragma unroll
              for (int n = 0; n < 4; ++n) ld_frag<2>(fV[n], sVt, TS, n * 16, fr, fq);
              const f32x4 dec = *(const LAS f32x4*)(sDec + wid * 16 + fq * 4);
              if (mt0 == 0) { acc[0] = mma_frag<2>(fP, fV[0], acc[0]); acc[1] = mma_frag<2>(fP, fV[2], acc[1]); }
              else { acc[0] = mma_frag<2>(fP, fV[1], acc[0]); acc[1] = mma_frag<2>(fP, fV[3], acc[1]); }
#pragma unroll
              for (int n = 0; n < 4; ++n) { ST[n] *= dec; ST[n] = mma_frag<2>(fKt, fV[n], ST[n]); }
#pragma unroll
              for (int n = 0; n < 4; ++n) { u32x2 w; w.x = pk2(ST[n][0], ST[n][1]); w.y = pk2(ST[n][2], ST[n][3]); *(LAS u32x2*)(sS + (n * 16 + fr) * QS + (wid * 16 + fq * 4) * 2) = w; } }
            { bf16* yp = Yo + (size_t)HG_TOK(ci, w3 * 16 + fq * 4) * D + h * 128 + slice * 64 + mt0 * 16 + fr;
              const long ystep = dir ? -(long)D : (long)D;
#pragma unroll
              for (int j = 0; j < 4; ++j) { yp[j * ystep] = (bf16)(pk2(acc[0][j], 0.f) & 0xffffu); yp[j * ystep + 32] = (bf16)(pk2(acc[1][j], 0.f) & 0xffffu); } }
            __syncthreads();
        }
#undef HG_LOAD
#undef HG_TOK
    }
}

#define XB_TMO      128
#define XB_XCNT(j)  (256  + 64 * (j))
#define XB_XSUB(j)  (1280 + 64 * (j))
#define XB_XGEN(j)  (2304 + 64 * (j))
#define XB_TOP      3328
#define XB_TOPGEN   3392
#define XCD_BAR_WORDS 3456
#define XB_SPIN_CAP (1u << 18)

__device__ __forceinline__ unsigned xb_ld(unsigned* p)              { return __hip_atomic_load(p, __ATOMIC_RELAXED, __HIP_MEMORY_SCOPE_AGENT); }
__device__ __forceinline__ unsigned xb_add(unsigned* p, unsigned v) { return __hip_atomic_fetch_add(p, v, __ATOMIC_RELAXED, __HIP_MEMORY_SCOPE_AGENT); }
__device__ __forceinline__ unsigned xb_xcc_id() { return (unsigned)__builtin_amdgcn_s_getreg((3 << 11) | 20) & 0xFu; }
#define XB_SPIN(cond, bar) do { unsigned _sp = 0; while (cond) { __builtin_amdgcn_s_sleep(1); \
    if ((++_sp & 255u) == 0u) { if (xb_ld(&(bar)[XB_TMO])) break; if (_sp > XB_SPIN_CAP) { atomicAdd(&(bar)[XB_TMO], 1u); break; } } } } while (0)

struct XcdBarrier {
    unsigned* bar; unsigned x;
    volatile LAS unsigned* st;
};

__device__ __forceinline__ XcdBarrier xcd_barrier_post(unsigned* bar, volatile LAS unsigned* st) {
    XcdBarrier b; b.bar = bar; b.x = xb_xcc_id(); b.st = st;
    if (threadIdx.x == 0) (void)xb_add(&bar[XB_XCNT(b.x)], 1u);
    return b;
}
__device__ __forceinline__ void xcd_barrier_complete(unsigned* bar, unsigned x, unsigned& nloc, unsigned& nx) {
    const unsigned G = gridDim.x * gridDim.y * gridDim.z;
    unsigned sum, cnt, mine, sp = 0u;
    for (;;) {
        sum = 0u; cnt = 0u; mine = 0u;
#pragma unroll
        for (unsigned j = 0; j < 16; ++j) { const unsigned c = xb_ld(&bar[XB_XCNT(j)]); sum += c; cnt += (c > 0u) ? 1u : 0u; mine = (j == x) ? c : mine; }
        if (sum == G) break;
        __builtin_amdgcn_s_sleep(1);
        if ((++sp & 255u) == 0u) { if (xb_ld(&bar[XB_TMO])) break; if (sp > XB_SPIN_CAP) { atomicAdd(&bar[XB_TMO], 1u); break; } }
    }
    nloc = mine > 0u ? mine : 1u; nx = cnt > 0u ? cnt : 1u;
}

__device__ __forceinline__ void xcd_barrier(const XcdBarrier& b) {
    asm volatile("s_waitcnt vmcnt(0)" ::: "memory");
    __syncthreads();
    if (threadIdx.x == 0) {
        unsigned* bar = b.bar;
        __builtin_amdgcn_s_waitcnt(0);
        unsigned nloc = b.st[0], nx = b.st[1];
        if (nloc == 0u) { xcd_barrier_complete(bar, b.x, nloc, nx); b.st[0] = nloc; b.st[1] = nx; }
        const unsigned old = xb_add(&bar[XB_XSUB(b.x)], 1u);
        const unsigned gen = old / nloc;
        if (old + 1u == (gen + 1u) * nloc) {
            __builtin_amdgcn_fence(__ATOMIC_RELEASE, "agent");
            asm volatile("s_waitcnt vmcnt(0)" ::: "memory");
            const unsigned og = xb_add(&bar[XB_TOP], 1u);
            const unsigned tg = og / nx;
            if (og + 1u == (tg + 1u) * nx) xb_add(&bar[XB_TOPGEN], 1u);
            else XB_SPIN(xb_ld(&bar[XB_TOPGEN]) == tg, bar);
            __builtin_amdgcn_fence(__ATOMIC_ACQUIRE, "agent");
            xb_add(&bar[XB_XGEN(b.x)], 1u);
            asm volatile("s_waitcnt vmcnt(0)" ::: "memory");
        } else {
            XB_SPIN(xb_ld(&bar[XB_XGEN(b.x)]) == gen, bar);
            __builtin_amdgcn_fence(__ATOMIC_ACQUIRE, "agent");
            asm volatile("s_waitcnt vmcnt(0)" ::: "memory");
        }
    }
    __syncthreads();
}

struct Args { const float* in[16]; float* out; unsigned char* ws; };
__global__ void __launch_bounds__(512, 2) fwd_megakernel(Args a) {
    extern __shared__ __attribute__((aligned(16))) unsigned char lds_raw[];
    cg::grid_group grid = cg::this_grid();
    ldsp lds = (ldsp)lds_raw;
    const int tid = threadIdx.x, lane = tid & 63, wave = __builtin_amdgcn_readfirstlane(tid >> 6);
    const int G_ = gridDim.x, bx = blockIdx.x;
    const int vcu = (G_ % 8 == 0) ? (bx % 8) * (G_ / 8) + bx / 8 : bx;
    const int gw = vcu * 8 + wave, NGW = G_ * 8;
    unsigned char* ws = a.ws;
    volatile LAS unsigned* MISC = (volatile LAS unsigned*)(lds + 131072 + 320);
    if (tid < 32) MISC[tid] = 0u;
    __syncthreads();
    XcdBarrier bar = xcd_barrier_post((unsigned*)ws, MISC + 8);
    if (ws == nullptr) grid.sync();
    const float* x = a.in[0]; const float* norm_mix_g = a.in[1]; const float* norm_ffn_g = a.in[2];
    const float* ml_w_in = a.in[3]; const float* ml_b_gate = a.in[4]; const float* ml_head_g = a.in[5]; const float* ml_w_out = a.in[6];
    const float* hg_w_in = a.in[7]; const float* hg_lb = a.in[8]; const float* hg_head_g = a.in[9]; const float* hg_w_out = a.in[10];
    const float* ffn_w_up = a.in[11]; const float* ffn_conv_w = a.in[12]; const float* ffn_conv_b = a.in[13]; const float* ffn_w_down = a.in[14]; const float* final_g = a.in[15];
    bf16* Win0 = (bf16*)(ws + WS_WIN0); bf16* Wout0 = (bf16*)(ws + WS_WOUT0); bf16* Win1 = (bf16*)(ws + WS_WIN1); bf16* Wout1 = (bf16*)(ws + WS_WOUT1);
    bf16* Wup = (bf16*)(ws + WS_WUP); bf16* Wdn = (bf16*)(ws + WS_WDN);
    float* SS = (float*)(ws + WS_SS); float* EDGE = (float*)(ws + WS_EDGE);
    bf16* HN = (bf16*)(ws + WS_HN); float* H = (float*)(ws + WS_H); float* G0 = (float*)(ws + WS_G0);
    bf16* PU = (bf16*)(ws + WS_PU); bf16* YF = (bf16*)(ws + WS_YF); bf16* YB = (bf16*)(ws + WS_YB); bf16* Y = (bf16*)(ws + WS_Y); bf16* Z = (bf16*)(ws + WS_Z);
#ifndef PHMASK
#define PHMASK 0xffff
#endif
#define PH(k) ((PHMASK >> (k)) & 1)
#define GSYNC() xcd_barrier(bar)

    if (PH(0)) {
        LAS float* scr = (LAS float*)(lds + wave * 16384);
        constexpr int I0 = 32 * (N_IN0 / 32), I1 = 32 * 64, I2 = 32 * (N_IN1 / 32), I3 = 32 * 64, I4 = 32 * (FF2 / 32), I5 = (FF / 64) * 64;
        constexpr int NITEMS = I0 + I1 + I4;
        for (int it = gw; it < NITEMS; it += NGW) {
            int r = it;
            if (r < I4) { p0_transpose_item(ffn_w_up, D, FF2, Wup, scr, r, lane, norm_ffn_g, true); continue; } r -= I4;
            if (r < I1) { p0_transpose_item(ml_w_out, D, D, Wout0, scr, r, lane); continue; } r -= I1;
            p0_transpose_item(ml_w_in, D, N_IN0, Win0, scr, r, lane, norm_mix_g);
        }
        cast_rows(x, HN, SS, gw, NGW, lane);
    }
    GSYNC();
#define RUN_LAYER(layer) do { \
        if (PH(1) && layer == 0) { \
            gate_gemm(lds, HN, Win0 + (size_t)LDP0 * D, SS, ml_b_gate, G0, bx, G_); \
            pg8::Gemm g{HN, Win0, T, LDP0, D}; pg8::StaticOrder S; S.init(T, LDP0, G_, bx); \
            pg8::EpiX<1> E{PU, LDP0, G0, ml_b_gate, SS + (size_t)2 * layer * T * 32}; \
            pg8::gemm_phase<pg8::EpiX<1>, pg8::StaticOrder, true, true>(lds, g, S, E); \
        } else if (PH(2)) { \
            pg8::Gemm g{HN, Win1, T, N_IN1, D}; pg8::StaticOrder S; S.init(T, N_IN1, G_, bx); \
            pg8::EpiX<2> E{PU, N_IN1, nullptr, hg_lb, SS + (size_t)2 * layer * T * 32}; \
            pg8::gemm_phase<pg8::EpiX<2>, pg8::StaticOrder, true, true>(lds, g, S, E); \
        } \
        GSYNC(); \
        if (layer == 0) { if (PH(3)) mlstm_phase(lds, PU, G0, YF, YB, vcu, G_); } else if (PH(4)) hgrn_phase(lds, PU, YF, YB, vcu, G_); \
        GSYNC(); \
        if (!PH(5)) {} else if (layer == 0) gatenorm<256, false>(YF, YB, PU + 4096, LDP0, ml_head_g, Y, gw, NGW, lane); \
        else gatenorm<128, true>(YF, YB, PU + 4096, N_IN1, hg_head_g, Y, gw, NGW, lane); \
        GSYNC(); \
        if (PH(6)) { \
            pg8::Gemm g{Y, layer == 0 ? Wout0 : Wout1, T, D, D}; pg8::StaticOrder S; S.init(T, D, G_, bx); \
            if (layer == 0) { pg8::EpiRes<true, true> E{x, D, HN, SS + (size_t)T * 32}; pg8::gemm_phase<pg8::EpiRes<true, true>, pg8::StaticOrder, true, true>(lds, g, S, E); } \
            else { pg8::EpiRes<false, true> E{nullptr, D, HN, SS + (size_t)3 * T * 32}; pg8::gemm_phase<pg8::EpiRes<false, true>, pg8::StaticOrder, true, true>(lds, g, S, E); } \
        } \
        GSYNC(); \
        if (PH(7)) { \
            pg8::Gemm g{HN, Wup + (size_t)layer * FF2 * D, T, FF2, D}; \
            pg8::EpiGLU E{Z, EDGE, ffn_conv_w + (size_t)layer * 3 * FF, ffn_conv_b + (size_t)layer * FF, SS + (size_t)(2 * layer + 1) * T * 32, (LAS float*)(lds + 131072 + 2048)}; \
            const int tail0 = (G_ > UP_TAIL) ? UP_TAIL : 0; \
            constexpr int J3 = 32 * 64, J5 = (FF / 64) * 64, NT_MAIN = 32 * 40, NT_ALL = 32 * (FF2 / 256); \
            constexpr int FE = 40 * 128;                         \
            const float* wu1 = ffn_w_up + (size_t)D * FF2; bf16* wu1t = Wup + (size_t)FF2 * D; \
            if (layer == 0) { \
                pg8::StaticOrder S; S.init(T, FF2, G_, bx); \
                pg8::gemm_phase<pg8::EpiGLU, pg8::StaticOrder, true, true>(lds, g, S, E); \
                if (bx >= tail0) {     \
                    { int tid3 = threadIdx.x; asm volatile("" : "+v"(tid3)); const int lane3 = tid3 & 63, wave3 = __builtin_amdgcn_readfirstlane(tid3 >> 6); \
                    const int tw = (bx - tail0) * 8 + wave3, tn = (G_ - tail0) * 8; LAS float* scr = (LAS float*)(lds + wave3 * 16384); \
                    p0_convert(P0Mat{wu1, wu1t, norm_ffn_g + D, D, FF - FE, true, FF2, FE}, 32 * ((FF - FE) / 32), tw, tn, lane3, scr); \
                    p0_convert(P0Mat{wu1, wu1t, norm_ffn_g + D, D, FF - FE, true, FF2, FF + FE}, 32 * ((FF - FE) / 32), tw, tn, lane3, scr); \
                    p0_convert(P0Mat{hg_w_out, Wout1, nullptr, D, D, false}, J3, tw, tn, lane3, scr); \
                    p0_convert(P0Mat{hg_w_in, Win1, norm_mix_g + D, D, N_IN1, false}, 32 * (N_IN1 / 32), tw, tn, lane3, scr); \
                    p0_convert(P0Mat{ffn_w_down, Wdn, nullptr, FF, D, false}, J5, tw, tn, lane3, scr); } \
                } \
            } else {     \
                { pg8::SubOrder S; S.init(T, FF2, G_, bx); S.lo = NT_MAIN; S.hi = NT_ALL; \
                  pg8::gemm_phase<pg8::EpiGLU, pg8::SubOrder, true, true>(lds, g, S, E); } \
                if (bx >= tail0) { \
                    { int tid3 = threadIdx.x; asm volatile("" : "+v"(tid3)); const int lane3 = tid3 & 63, wave3 = __builtin_amdgcn_readfirstlane(tid3 >> 6); \
                    const int tw = (bx - tail0) * 8 + wave3, tn = (G_ - tail0) * 8; LAS float* scr = (LAS float*)(lds + wave3 * 16384); \
                    p0_convert(P0Mat{wu1, wu1t, norm_ffn_g + D, D, FE, true, FF2, 0}, 32 * (FE / 32), tw, tn, lane3, scr); \
                    p0_convert(P0Mat{wu1, wu1t, norm_ffn_g + D, D, FE, true, FF2, FF}, 32 * (FE / 32), tw, tn, lane3, scr); \
                    p0_convert(P0Mat{ffn_w_down + (size_t)FF * D, Wdn + (size_t)D * FF, nullptr, FF, D, false}, J5, tw, tn, lane3, scr); } \
                } \
                GSYNC(); \
                { pg8::SubOrder S; S.init(T, FF2, G_, bx); S.lo = 0; S.hi = NT_MAIN; \
                  pg8::gemm_phase<pg8::EpiGLU, pg8::SubOrder, true, true>(lds, g, S, E); } \
            } \
        } \
        GSYNC(); \
        if (PH(9)) { \
            pg8::Gemm g{Z, Wdn + (size_t)layer * D * FF, T, D, FF}; pg8::StaticOrder S; S.init(T, D, G_, bx); \
            { pg8::Unit u0; S.next(0, u0); glu_fixup(EDGE, ffn_conv_w + (size_t)layer * 3 * FF, ffn_conv_b + (size_t)layer * FF, Z, u0.pm); } \
            if (layer == 0) { pg8::EpiRes<false, true> E{nullptr, D, HN, SS + (size_t)2 * T * 32}; pg8::gemm_phase<pg8::EpiRes<false, true>, pg8::StaticOrder, true, true>(lds, g, S, E); } \
            else { pg8::EpiRes<false, false> E{nullptr, D, HN, nullptr}; pg8::gemm_phase<pg8::EpiRes<false, false>, pg8::StaticOrder, true, true>(lds, g, S, E); } \
        } \
        GSYNC(); \
     \
    } while (0)
    RUN_LAYER(0);
    RUN_LAYER(1);
    { int tid2 = threadIdx.x; asm volatile("" : "+v"(tid2));
      const int lane2 = tid2 & 63, gw2 = vcu * 8 + (tid2 >> 6);
      rms_rows_final(HN, final_g, a.out, gw2, NGW, lane2); }
}

extern "C" void kernel_launch(void* const* d_in, const int* in_sizes, int n_in, void* d_out, int out_size, void* d_ws, size_t ws_size, hipStream_t stream) {
    static int grid = 0;
    if (grid == 0) {
        if (n_in != 16 || out_size != T * D || ws_size < WS_END2) { fprintf(stderr, "kernel_launch: unexpected problem (n_in %d, out %d, ws %zu)\n", n_in, out_size, ws_size); grid = -1; return; }
        int dev = 0, cus = 0, per_cu = 0;
        hipGetDevice(&dev); hipDeviceGetAttribute(&cus, hipDeviceAttributeMultiprocessorCount, dev);
        if (hipFuncSetAttribute((const void*)fwd_megakernel, hipFuncAttributeMaxDynamicSharedMemorySize, LDS_BYTES) != hipSuccess) { fprintf(stderr, "kernel_launch: hipFuncSetAttribute failed\n"); grid = -1; return; }
        if (hipOccupancyMaxActiveBlocksPerMultiprocessor(&per_cu, (const void*)fwd_megakernel, 512, LDS_BYTES) != hipSuccess || per_cu < 1) { fprintf(stderr, "kernel_launch: occupancy query failed (%d)\n", per_cu); (void)hipGetLastError(); per_cu = 1; }
        grid = cus * per_cu;
    }
    if (grid < 0) return;
    if (hipMemsetAsync(d_ws, 0, 16384, stream) != hipSuccess) { fprintf(stderr, "kernel_launch: memset failed\n"); return; }
    Args a{};
    for (int i = 0; i < 16; ++i) a.in[i] = (const float*)d_in[i];
    a.out = (float*)d_out; a.ws = (unsigned char*)d_ws;
    void* args[] = {&a};
    hipError_t e = hipLaunchCooperativeKernel((const void*)fwd_megakernel, dim3(grid), dim3(512), args, LDS_BYTES, stream);
    if (e != hipSuccess) fprintf(stderr, "kernel_launch: cooperative launch failed: %s (grid %d)\n", hipGetErrorString(e), grid);
}
```
